# Optimizing an MI355X kernel written in HIP

```python
import math
import jax
import jax.numpy as jnp
from jax import lax
import numpy as np

D_MODEL = 4096
BATCH = 4
SEQ = 2048
DEPTH = 1
DEC_BATCH = 128
DEC_SEQ = 4
PAST_LEN = 16384
PAGE_SIZE = 128

SSM_WIDTH = D_MODEL // 2
SSM_GROUP = 16
SSM_GROUPS = SSM_WIDTH // SSM_GROUP
SSM_STATE = 64
DT_MIN = 1e-3
DT_MAX = 1e-1
CONV_WIDTH = D_MODEL // 2
CONV_K = 3
IN_WIDTHS = (SSM_WIDTH, SSM_WIDTH, CONV_WIDTH, CONV_WIDTH, CONV_WIDTH, CONV_WIDTH, D_MODEL, D_MODEL)
IN_COLS = 2 * SSM_WIDTH + 4 * CONV_WIDTH + 2 * D_MODEL
EPS = 1e-6

kernel_name = "hybrid_s5_shortconv_gated_decoder_step"


def _rmsnorm(x, g):
    xf = x.astype(jnp.float32)
    y = xf * lax.rsqrt(jnp.mean(xf * xf, axis=-1, keepdims=True) + EPS)
    return (y * g.astype(jnp.float32)).astype(x.dtype)


def _s5(u, h0, lam_re, lam_im, log_dt, b_re, b_im, c_re, c_im, d_skip):
    n, l, _ = u.shape
    f32 = jnp.float32
    uf = u.astype(f32).reshape(n, l, SSM_GROUPS, SSM_GROUP)
    lam = lax.complex(lam_re.astype(f32), lam_im.astype(f32))
    dt = jnp.exp(log_dt.astype(f32))[:, None]
    lam_bar = jnp.exp(lam * dt)
    b = lax.complex(b_re.astype(f32), b_im.astype(f32))
    b_bar = ((lam_bar - 1.0) / lam)[..., None] * b
    bu = jnp.einsum('gph,nlgh->nlgp', b_bar, uf.astype(jnp.complex64))
    a = jnp.broadcast_to(lam_bar, bu.shape)

    def combine(e1, e2):
        a1, b1 = e1
        a2, b2 = e2
        return a1 * a2, a2 * b1 + b2

    a_cum, h = lax.associative_scan(combine, (a, bu), axis=1)
    h0c = lax.complex(h0[..., 0].astype(f32), h0[..., 1].astype(f32))
    h = h + a_cum * h0c[:, None]
    c = lax.complex(c_re.astype(f32), c_im.astype(f32))
    y = jnp.einsum('ghp,nlgp->nlgh', c, h).real \
        + d_skip.astype(f32).reshape(SSM_GROUPS, SSM_GROUP) * uf
    h_last = h[:, -1]
    new_state = jnp.stack([h_last.real, h_last.imag], axis=-1)
    return y.reshape(n, l, SSM_WIDTH).astype(u.dtype), new_state


def _short_conv(v, buf, w):
    l = v.shape[1]
    full = jnp.concatenate([buf.astype(v.dtype), v], axis=1)
    out = full[:, 0:l] * w[0]
    for k in range(1, CONV_K):
        out = out + full[:, k:k + l] * w[k]
    return out, full[:, -(CONV_K - 1):]


def _layer(x, c, ssm_h0, conv_buf, norm_g, w_ada, b_ada, w_in, lam_re, lam_im, log_dt,
           b_re, b_im, c_re, c_im, d_skip, w_glu, b_glu, w_pa, conv_w, w_pb, w_o):
    mod = jax.nn.silu(c) @ w_ada + b_ada
    shift, scale, gate = jnp.split(mod, 3, axis=-1)
    xn = _rmsnorm(x, norm_g) * (1.0 + scale[:, None]) + shift[:, None]
    proj = xn @ w_in
    split_points = np.cumsum(IN_WIDTHS)[:-1].tolist()
    u_a, z_a, h_b, c_b, b_b, z_b, g_a, g_b = jnp.split(proj, split_points, axis=-1)
    y_a, ssm_new = _s5(u_a, ssm_h0, lam_re, lam_im, log_dt, b_re, b_im, c_re, c_im, d_skip)
    y_a = jax.nn.gelu(y_a)
    y_a = y_a * jax.nn.sigmoid(y_a @ w_glu + b_glu)
    branch_a = (y_a * jax.nn.silu(z_a)) @ w_pa
    conv_out, conv_new = _short_conv(c_b * h_b, conv_buf, conv_w)
    branch_b = (b_b * conv_out * jax.nn.silu(z_b)) @ w_pb
    merged = jax.nn.sigmoid(g_a) * branch_a + jax.nn.sigmoid(g_b) * branch_b
    out = merged @ w_o
    return x + gate[:, None] * out, ssm_new, conv_new


def setup_inputs(seed: int = 0) -> dict:
    key = jax.random.key(seed)
    ks = jax.random.split(key, 32)
    f32 = jnp.float32
    nrm = lambda k, shape, s: (jax.random.normal(k, shape, f32) * s)
    lam_im_base = math.pi * jnp.arange(SSM_STATE, dtype=f32)
    return {
        "x_prompt": nrm(ks[0], (BATCH, SEQ, D_MODEL), 1.0),
        "x_sample": nrm(ks[1], (DEC_BATCH, DEC_SEQ, D_MODEL), 1.0),
        "state_ssm": nrm(ks[2], (DEPTH, DEC_BATCH, SSM_GROUPS, SSM_STATE, 2), 0.1),
        "state_conv": nrm(ks[3], (DEPTH, DEC_BATCH, CONV_K - 1, CONV_WIDTH), 1.0),
        "c_prompt": nrm(ks[4], (BATCH, D_MODEL), 1.0),
        "c_sample": nrm(ks[5], (DEC_BATCH, D_MODEL), 1.0),
        "norm_g": 1.0 + nrm(ks[6], (DEPTH, D_MODEL), 0.02),
        "w_ada": nrm(ks[7], (DEPTH, D_MODEL, 3 * D_MODEL), 0.5 * D_MODEL ** -0.5),
        "b_ada": nrm(ks[8], (DEPTH, 3 * D_MODEL), 0.02),
        "w_in": nrm(ks[9], (DEPTH, D_MODEL, IN_COLS), D_MODEL ** -0.5),
        "lam_re": -0.5 + nrm(ks[10], (DEPTH, SSM_GROUPS, SSM_STATE), 0.01),
        "lam_im": lam_im_base + nrm(ks[11], (DEPTH, SSM_GROUPS, SSM_STATE), 0.01),
        "log_dt": jax.random.uniform(ks[12], (DEPTH, SSM_GROUPS), f32,
                                     minval=math.log(DT_MIN), maxval=math.log(DT_MAX)),
        "b_re": nrm(ks[13], (DEPTH, SSM_GROUPS, SSM_STATE, SSM_GROUP), (2 * SSM_GROUP) ** -0.5),
        "b_im": nrm(ks[14], (DEPTH, SSM_GROUPS, SSM_STATE, SSM_GROUP), (2 * SSM_GROUP) ** -0.5),
        "c_re": nrm(ks[15], (DEPTH, SSM_GROUPS, SSM_GROUP, SSM_STATE), 0.5),
        "c_im": nrm(ks[16], (DEPTH, SSM_GROUPS, SSM_GROUP, SSM_STATE), 0.5),
        "d_skip": nrm(ks[17], (DEPTH, SSM_WIDTH), 1.0),
        "w_glu": nrm(ks[18], (DEPTH, SSM_WIDTH, SSM_WIDTH), SSM_WIDTH ** -0.5),
        "b_glu": nrm(ks[19], (DEPTH, SSM_WIDTH), 0.02),
        "w_pa": nrm(ks[20], (DEPTH, SSM_WIDTH, D_MODEL), SSM_WIDTH ** -0.5),
        "conv_w": nrm(ks[21], (DEPTH, CONV_K, CONV_WIDTH), CONV_K ** -0.5),
        "w_pb": nrm(ks[22], (DEPTH, CONV_WIDTH, D_MODEL), CONV_WIDTH ** -0.5),
        "w_o": nrm(ks[23], (DEPTH, D_MODEL, D_MODEL), D_MODEL ** -0.5),
        "final_g": 1.0 + nrm(ks[24], (D_MODEL,), 0.02),
    }


def reference(x_prompt, x_sample, state_ssm, state_conv, c_prompt, c_sample, norm_g, w_ada, b_ada,
              w_in, lam_re, lam_im, log_dt, b_re, b_im, c_re, c_im, d_skip, w_glu, b_glu, w_pa,
              conv_w, w_pb, w_o, final_g):
    n_p = x_prompt.shape[0]
    ssm_p0 = jnp.zeros((n_p, SSM_GROUPS, SSM_STATE, 2), jnp.float32)
    conv_p0 = jnp.zeros((n_p, CONV_K - 1, CONV_WIDTH), x_prompt.dtype)
    hp, hs = x_prompt, x_sample
    ssm_p_all, conv_p_all, ssm_s_all, conv_s_all = [], [], [], []
    for l in range(DEPTH):
        params = (norm_g[l], w_ada[l], b_ada[l], w_in[l], lam_re[l], lam_im[l], log_dt[l],
                  b_re[l], b_im[l], c_re[l], c_im[l], d_skip[l], w_glu[l], b_glu[l], w_pa[l],
                  conv_w[l], w_pb[l], w_o[l])
        hp, sp, cp = _layer(hp, c_prompt, ssm_p0, conv_p0, *params)
        hs, ss, cs = _layer(hs, c_sample, state_ssm[l], state_conv[l], *params)
        ssm_p_all.append(sp)
        conv_p_all.append(cp)
        ssm_s_all.append(ss)
        conv_s_all.append(cs)
    y_prompt = _rmsnorm(hp, final_g)
    y_sample = _rmsnorm(hs, final_g)
    return (y_prompt, y_sample, jnp.stack(ssm_p_all), jnp.stack(conv_p_all),
            jnp.stack(ssm_s_all), jnp.stack(conv_s_all))
```

```cpp
#include <hip/hip_runtime.h>
#include <hip/hip_cooperative_groups.h>
#include <cstdio>
#include <cstdint>
namespace cg = cooperative_groups;

#ifndef MK_N_LAUNCHES
#define MK_N_LAUNCHES 1
#endif

#define LAS __attribute__((address_space(3)))
typedef unsigned short bf16_t;
typedef short bf16x8 __attribute__((ext_vector_type(8)));
typedef float f32x4 __attribute__((ext_vector_type(4)));
typedef float f32x2 __attribute__((ext_vector_type(2)));
typedef float f32x16 __attribute__((ext_vector_type(16)));
typedef unsigned u32x4 __attribute__((ext_vector_type(4)));
typedef unsigned u32x2 __attribute__((ext_vector_type(2)));
typedef short v4i16_t __attribute__((ext_vector_type(4)));

constexpr int D = 4096, MP = 8192, MS = 512, M = MP + MS, LP = 2048, LS = 4, NSEQ_P = 4, NSEQ_S = 128, NMOD = 132;
constexpr int INC = 20480, SW = 2048, NG = 128, NST = 64, HG = 16;
constexpr int C_UA = 0, C_ZA = 2048, C_HB = 4096, C_CB = 6144, C_BB = 8192, C_ZB = 10240, C_GA = 12288, C_GB = 16384;
constexpr float EPS = 1e-6f;
constexpr size_t O_Y = 0, O_SSM_P = (size_t)M * D, O_CONV_P = O_SSM_P + 65536, O_SSM_S = O_CONV_P + 16384, O_CONV_S = O_SSM_S + 2097152;

constexpr size_t MiB = 1u << 20;
constexpr size_t WS_WIN = 1 * MiB;
constexpr size_t WS_WGLU = WS_WIN + 160 * MiB;
constexpr size_t WS_WPAB = WS_WGLU + 8 * MiB;
constexpr size_t WS_WO = WS_WPAB + 32 * MiB;
constexpr size_t WS_WADA = WS_WO + 32 * MiB;
constexpr size_t WS_SC = WS_WADA + 96 * MiB;
constexpr size_t WS_MODP = WS_SC + 2 * MiB;
constexpr size_t WS_GATE = WS_MODP + 26 * MiB;
constexpr size_t WS_SEG = WS_GATE + 3 * MiB;
constexpr size_t WS_SSQ = WS_SEG + 2 * MiB;
constexpr size_t WS_XN = WS_SSQ + 3 * MiB;
constexpr size_t WS_PROJ = WS_XN + 68 * MiB;
constexpr size_t WS_YA = WS_PROJ + 340 * MiB;
constexpr size_t WS_PAB = WS_YA + 34 * MiB;
constexpr size_t WS_MERGED = WS_PAB + 68 * MiB;
constexpr size_t WS_END = WS_MERGED + 68 * MiB;

constexpr int NWAVES = 8, NTHREADS = 512;
constexpr int LDS_BYTES = 135168;

__device__ __forceinline__ unsigned cvt_pk_bf16(float lo, float hi) { unsigned r; asm volatile("v_cvt_pk_bf16_f32 %0, %1, %2" : "=v"(r) : "v"(lo), "v"(hi)); return r; }
__device__ __forceinline__ float bf_lo(unsigned w) { return __uint_as_float(w << 16); }
__device__ __forceinline__ float bf_hi(unsigned w) { return __uint_as_float(w & 0xffff0000u); }
__device__ __forceinline__ float sigmoidf_(float v) { return __builtin_amdgcn_rcpf(1.0f + __expf(-v)); }
__device__ __forceinline__ float wave_sum(float v) {
#pragma unroll
    for (int o = 1; o < 64; o <<= 1) v += __shfl_xor(v, o);
    return v;
}
__device__ __forceinline__ void unpack8(const u32x4 w, float (&f)[8]) {
    f[0] = bf_lo(w.x); f[1] = bf_hi(w.x); f[2] = bf_lo(w.y); f[3] = bf_hi(w.y); f[4] = bf_lo(w.z); f[5] = bf_hi(w.z); f[6] = bf_lo(w.w); f[7] = bf_hi(w.w);
}

namespace pg8 {
constexpr int BM = 256, BK = 64, HALF = 128, HTB = HALF * BK * 2, STAGE_BYTES = 8 * HTB, NXCD = 8, WGM = 8;
__host__ __device__ __forceinline__ int lds_byte(int r, int c) { const int st = (r >> 4) * 2 + (c >> 5), rr = r & 15, cc = c & 31, ob = rr * 64 + cc * 2; return st * 1024 + (ob ^ (((ob >> 9) & 1) << 5)); }
__host__ __device__ __forceinline__ void stage_rc(int b, int& R, int& C) { const int st = b / 1024, sb = b % 1024, swz = sb ^ (((sb >> 9) & 1) << 5); R = (st >> 1) * 16 + swz / 64; C = (st & 1) * 32 + (swz % 64) / 2; }
__host__ __device__ __forceinline__ int perm32(int rho) { const int n = rho >> 4, i = rho & 15; return 8 * (i >> 2) + 4 * n + (i & 3); }

struct Unit { int pm, pn, part; };
struct Gemm { const bf16_t* A; const bf16_t* Bt; int lda, ldb, K; };

struct TileOrder {
    int nM, nN, nwg, G, c;
    __device__ void init(int M_, int N_, int G_, int c_) { nM = M_ / BM; nN = N_ / BM; nwg = nM * nN; G = G_; c = c_; }
    __device__ bool tile(int i, int& pm, int& pn) const {
        const long L = (long)i * G + c; if (L >= nwg) return false;
        int wgid = (int)L; { const int q = nwg / NXCD, r = nwg % NXCD, xcd = wgid % NXCD, off = wgid / NXCD; wgid = (xcd < r ? xcd * (q + 1) : r * (q + 1) + (xcd - r) * q) + off; }
        const int nig = WGM * nN, gid = wgid / nig, fm = gid * WGM, gsz = (nM - fm) < WGM ? (nM - fm) : WGM;
        pm = fm + ((wgid % nig) % gsz); pn = (wgid % nig) / gsz; return true;
    }
};
struct SchedPlain { TileOrder T; __device__ bool next(int i, Unit& u) const { u.part = 0; return T.tile(i, u.pm, u.pn); } };
struct SchedHalves { TileOrder T; __device__ bool next(int i, Unit& u) const { u.part = i & 1; return T.tile(i >> 1, u.pm, u.pn); } };
struct SchedMod { int G, c; __device__ bool next(int i, Unit& u) const { const int L = i * G + c; if (L >= 192) return false; u.pm = 0; u.pn = L % 48; u.part = L / 48; return true; } };

typedef f32x4 Acc[2][2][4][2];

template <class Epi, class Sched>
__device__ __forceinline__ void gemm_phase(LAS unsigned char* lds, const Gemm g, const Sched& S, const Epi& E) {
    const int tid = threadIdx.x, wid = __builtin_amdgcn_readfirstlane(tid >> 6), lane = tid & 63, wr = wid >> 2, wc = wid & 3, fr = lane & 15, fq = lane >> 4;
    const int K = g.K, nt = K / BK;
    unsigned voffA[2], voffB[2];
#pragma unroll
    for (int i = 0; i < 2; ++i) { int R, C; stage_rc(tid * 16 + i * 8192, R, C); const int Rb = (R & ~31) + perm32(R & 31);
        voffA[i] = (unsigned)(R * g.lda + C) * 2u; voffB[i] = (unsigned)(Rb * g.ldb + C) * 2u; }
    const size_t kstep = (size_t)(BK * 2);
    const size_t hstepA = (size_t)HALF * g.lda * 2, hstepB = (size_t)HALF * g.ldb * 2;
    const unsigned ldsw = (unsigned)wid * 1024u;
    const int aoff = lds_byte(wr * 64 + fr, fq * 8), boff = lds_byte(wc * 32 + fr, fq * 8);
#define PG8_SA(b, h) (((b) * 2 + (h)) * HTB)
#define PG8_SB(b, h) ((4 + (b) * 2 + (h)) * HTB)
#define PG8_STAGE(bufoff, gbase, voff) do { _Pragma("unroll") for (int _i = 0; _i < 2; ++_i) \
        __builtin_amdgcn_global_load_lds((const unsigned*)((const char*)(gbase) + (voff)[_i]), (LAS unsigned*)(lds + (bufoff) + ldsw + _i * 8192), 16, 0, 0); } while (0)
#define PG8_LDA(dst, b, h) do { _Pragma("unroll") for (int m = 0; m < 4; ++m) _Pragma("unroll") for (int k = 0; k < 2; ++k) dst[m][k] = *(const LAS bf16x8*)(lds + PG8_SA(b, h) + aoff + m * 2048 + k * 1024); } while (0)
#define PG8_LDB(dst, b, h) do { _Pragma("unroll") for (int n = 0; n < 2; ++n) _Pragma("unroll") for (int k = 0; k < 2; ++k) dst[n][k] = *(const LAS bf16x8*)(lds + PG8_SB(b, h) + boff + n * 2048 + k * 1024); } while (0)
#define PG8_MMA(ai, bj, At, Bt) do { __builtin_amdgcn_s_setprio(1); _Pragma("unroll") for (int m = 0; m < 4; ++m) _Pragma("unroll") for (int n = 0; n < 2; ++n) _Pragma("unroll") for (int k = 0; k < 2; ++k) \
        acc[ai][bj][m][n] = __builtin_amdgcn_mfma_f32_16x16x32_bf16(Bt[n][k], At[m][k], acc[ai][bj][m][n], 0, 0, 0); __builtin_amdgcn_s_setprio(0); } while (0)
#define PG8_WAIT_V(n) asm volatile("s_waitcnt vmcnt(" #n ")" ::: "memory")
#define PG8_WAIT_L(n) asm volatile("s_waitcnt lgkmcnt(" #n ")" ::: "memory")
#define PG8_BAR __builtin_amdgcn_s_barrier()
#define PG8_SCHED __builtin_amdgcn_sched_barrier(0)
    Unit cur, nxt; int ui = 0;
    if (!S.next(0, cur)) return;
    Acc acc;
#pragma unroll
    for (int a = 0; a < 2; ++a)
#pragma unroll
        for (int b = 0; b < 2; ++b)
#pragma unroll
            for (int m = 0; m < 4; ++m)
#pragma unroll
                for (int n = 0; n < 2; ++n) acc[a][b][m][n] = (f32x4){0.f, 0.f, 0.f, 0.f};
    bf16x8 At[4][2], B0[2][2], B1[2][2];
    const char* cA = (const char*)g.A + ((size_t)cur.pm * BM * g.lda + (size_t)cur.part * K) * 2;
    const char* cB = (const char*)g.Bt + ((size_t)cur.pn * BM * g.ldb + (size_t)cur.part * K) * 2;
    PG8_STAGE(PG8_SB(0, 0), cB, voffB); PG8_STAGE(PG8_SB(0, 1), cB + hstepB, voffB); PG8_STAGE(PG8_SA(0, 0), cA, voffA); PG8_STAGE(PG8_SA(0, 1), cA + hstepA, voffA);
    if (wr == 1) PG8_BAR;
    PG8_WAIT_V(2); PG8_BAR;
    PG8_STAGE(PG8_SB(1, 0), cB + kstep, voffB); PG8_STAGE(PG8_SA(1, 0), cA + kstep, voffA); PG8_STAGE(PG8_SB(1, 1), cB + hstepB + kstep, voffB);
    PG8_WAIT_V(6); PG8_BAR;
    for (;;) {
        const bool has_next = S.next(ui + 1, nxt);
        const char* nA = has_next ? (const char*)g.A + ((size_t)nxt.pm * BM * g.lda + (size_t)nxt.part * K) * 2 : cA;
        const char* nB = has_next ? (const char*)g.Bt + ((size_t)nxt.pn * BM * g.ldb + (size_t)nxt.part * K) * 2 : cB;
        for (int t = 0; t < nt; t += 2) {
            const bool last = (t == nt - 2);
            const char* a1 = cA + (size_t)(t + 1) * kstep;
            const char* a2 = last ? nA : cA + (size_t)(t + 2) * kstep; const char* b2 = last ? nB : cB + (size_t)(t + 2) * kstep;
            const char* a3 = a2 + kstep; const char* b3 = b2 + kstep;
            PG8_LDB(B0, 0, 0); PG8_LDB(B1, 0, 1); PG8_SCHED; PG8_LDA(At, 0, 0); PG8_STAGE(PG8_SA(1, 1), a1 + hstepA, voffA);
            PG8_WAIT_V(8); PG8_WAIT_L(0); PG8_BAR; PG8_MMA(0, 0, At, B0); PG8_MMA(0, 1, At, B1); PG8_BAR; PG8_SCHED;
            PG8_LDA(At, 0, 1); PG8_STAGE(PG8_SB(0, 0), b2, voffB); PG8_STAGE(PG8_SB(0, 1), b2 + hstepB, voffB); PG8_STAGE(PG8_SA(0, 0), a2, voffA);
            PG8_WAIT_V(8); PG8_WAIT_L(0); PG8_BAR; PG8_MMA(1, 0, At, B0); PG8_MMA(1, 1, At, B1); PG8_BAR; PG8_SCHED;
            PG8_LDB(B0, 1, 0); PG8_LDB(B1, 1, 1); PG8_SCHED; PG8_LDA(At, 1, 0); PG8_STAGE(PG8_SA(0, 1), a2 + hstepA, voffA);
            PG8_WAIT_V(8); PG8_WAIT_L(0); PG8_BAR; PG8_MMA(0, 0, At, B0); PG8_MMA(0, 1, At, B1); PG8_BAR; PG8_SCHED;
            PG8_LDA(At, 1, 1); PG8_STAGE(PG8_SB(1, 0), b3, voffB); PG8_STAGE(PG8_SB(1, 1), b3 + hstepB, voffB); PG8_STAGE(PG8_SA(1, 0), a3, voffA);
            PG8_WAIT_V(8); PG8_WAIT_L(0); PG8_BAR; PG8_MMA(1, 0, At, B0); PG8_MMA(1, 1, At, B1); PG8_BAR; PG8_SCHED;
        }
        if (wr == 0) PG8_BAR;
        const bool keep = E(acc, cur, wr, wc, fr, fq);
        if (!has_next) break;
        if (!keep) {
#pragma unroll
            for (int a = 0; a < 2; ++a)
#pragma unroll
                for (int b = 0; b < 2; ++b)
#pragma unroll
                    for (int m = 0; m < 4; ++m)
#pragma unroll
                        for (int n = 0; n < 2; ++n) acc[a][b][m][n] = (f32x4){0.f, 0.f, 0.f, 0.f};
        }
        cur = nxt; cA = nA; cB = nB; ++ui;
        if (wr == 1) PG8_BAR;
    }
    PG8_WAIT_V(0);
    PG8_BAR;
#undef PG8_SA
#undef PG8_SB
#undef PG8_STAGE
#undef PG8_LDA
#undef PG8_LDB
#undef PG8_MMA
#undef PG8_WAIT_V
#undef PG8_WAIT_L
#undef PG8_BAR
#undef PG8_SCHED
}

#define EPI_ROWS(ai, m) (u.pm * BM + (ai) * HALF + wr * 64 + (m) * 16 + fr)
#define EPI_COL0 (u.pn * BM + wc * 32 + 8 * fq)

struct EpiMod {
    float* modp;
    __device__ __forceinline__ bool operator()(Acc& acc, const Unit& u, int wr, int wc, int fr, int fq) const {
        const int col0 = EPI_COL0;
#pragma unroll
        for (int ai = 0; ai < 2; ++ai)
#pragma unroll
            for (int m = 0; m < 4; ++m) { const int row = EPI_ROWS(ai, m);
                if (row < NMOD) { float* rowp = modp + ((size_t)u.part * NMOD + row) * 12288 + col0;
#pragma unroll
                    for (int bj = 0; bj < 2; ++bj) { *(f32x4*)(rowp + bj * HALF) = acc[ai][bj][m][0]; *(f32x4*)(rowp + bj * HALF + 4) = acc[ai][bj][m][1]; } } }
        return false;
    }
};
struct EpiProj {
    bf16_t* O;
    __device__ __forceinline__ bool operator()(Acc& acc, const Unit& u, int wr, int wc, int fr, int fq) const {
        const int col0 = EPI_COL0; const int cb = u.pn >> 3;
        const int act = (cb == 1 || cb == 5) ? 1 : (cb >= 6 ? 2 : 0);
#pragma unroll
        for (int ai = 0; ai < 2; ++ai)
#pragma unroll
            for (int m = 0; m < 4; ++m) { bf16_t* rowp = O + (size_t)EPI_ROWS(ai, m) * INC + col0;
#pragma unroll
                for (int bj = 0; bj < 2; ++bj) { f32x4 v0 = acc[ai][bj][m][0], v1 = acc[ai][bj][m][1];
                    if (act) {
#pragma unroll
                        for (int j = 0; j < 4; ++j) { const float s0 = sigmoidf_(v0[j]), s1 = sigmoidf_(v1[j]); v0[j] = act == 1 ? v0[j] * s0 : s0; v1[j] = act == 1 ? v1[j] * s1 : s1; } }
                    u32x4 w; w.x = cvt_pk_bf16(v0[0], v0[1]); w.y = cvt_pk_bf16(v0[2], v0[3]); w.z = cvt_pk_bf16(v1[0], v1[1]); w.w = cvt_pk_bf16(v1[2], v1[3]);
                    *(u32x4*)(rowp + bj * HALF) = w; } }
        return false;
    }
};
struct EpiGlu {
    const bf16_t* ya; const bf16_t* proj; const float* bglu; bf16_t* pab;
    __device__ __forceinline__ bool operator()(Acc& acc, const Unit& u, int wr, int wc, int fr, int fq) const {
        const int col0 = EPI_COL0;
        f32x4 bv[2][2];
#pragma unroll
        for (int bj = 0; bj < 2; ++bj) { bv[bj][0] = *(const f32x4*)(bglu + col0 + bj * HALF); bv[bj][1] = *(const f32x4*)(bglu + col0 + bj * HALF + 4); }
#pragma unroll
        for (int ai = 0; ai < 2; ++ai)
#pragma unroll
            for (int m = 0; m < 4; ++m) { const size_t row = EPI_ROWS(ai, m);
#pragma unroll
                for (int bj = 0; bj < 2; ++bj) {
                    const u32x4 yw = *(const u32x4*)(ya + row * SW + col0 + bj * HALF), zw = *(const u32x4*)(proj + row * INC + C_ZA + col0 + bj * HALF);
                    float y[8], z[8], o[8]; unpack8(yw, y); unpack8(zw, z);
                    const f32x4 t0 = acc[ai][bj][m][0] + bv[bj][0], t1 = acc[ai][bj][m][1] + bv[bj][1];
#pragma unroll
                    for (int j = 0; j < 4; ++j) { o[j] = y[j] * sigmoidf_(t0[j]) * z[j]; o[4 + j] = y[4 + j] * sigmoidf_(t1[j]) * z[4 + j]; }
                    u32x4 w; w.x = cvt_pk_bf16(o[0], o[1]); w.y = cvt_pk_bf16(o[2], o[3]); w.z = cvt_pk_bf16(o[4], o[5]); w.w = cvt_pk_bf16(o[6], o[7]);
                    *(u32x4*)(pab + row * D + col0 + bj * HALF) = w; } }
        return false;
    }
};
struct EpiBranch {
    const bf16_t* proj; bf16_t* merged;
    __device__ __forceinline__ bool operator()(Acc& acc, const Unit& u, int wr, int wc, int fr, int fq) const {
        const int col0 = EPI_COL0;
#pragma unroll
        for (int ai = 0; ai < 2; ++ai)
#pragma unroll
            for (int m = 0; m < 4; ++m) { const size_t row = EPI_ROWS(ai, m);
#pragma unroll
                for (int bj = 0; bj < 2; ++bj) {
                    const u32x4 gbw = *(const u32x4*)(proj + row * INC + C_GB + col0 + bj * HALF); float gb[8]; unpack8(gbw, gb);
                    if (u.part == 0) {
                        const u32x4 gaw = *(const u32x4*)(proj + row * INC + C_GA + col0 + bj * HALF); float ga[8]; unpack8(gaw, ga);
#pragma unroll
                        for (int j = 0; j < 4; ++j) { acc[ai][bj][m][0][j] *= ga[j] * __builtin_amdgcn_rcpf(fmaxf(gb[j], 1e-30f)); acc[ai][bj][m][1][j] *= ga[4 + j] * __builtin_amdgcn_rcpf(fmaxf(gb[4 + j], 1e-30f)); }
                    } else {
                        float o[8];
#pragma unroll
                        for (int j = 0; j < 4; ++j) { o[j] = acc[ai][bj][m][0][j] * fmaxf(gb[j], 1e-30f); o[4 + j] = acc[ai][bj][m][1][j] * fmaxf(gb[4 + j], 1e-30f); }
                        u32x4 w; w.x = cvt_pk_bf16(o[0], o[1]); w.y = cvt_pk_bf16(o[2], o[3]); w.z = cvt_pk_bf16(o[4], o[5]); w.w = cvt_pk_bf16(o[6], o[7]);
                        *(u32x4*)(merged + row * D + col0 + bj * HALF) = w; } } }
        return u.part == 0;
    }
};
struct EpiOut {
    const float* xp; const float* xs; const float* gate; float* out; float* ssq;
    __device__ __forceinline__ bool operator()(Acc& acc, const Unit& u, int wr, int wc, int fr, int fq) const {
        const int col0 = EPI_COL0;
#pragma unroll
        for (int ai = 0; ai < 2; ++ai)
#pragma unroll
            for (int m = 0; m < 4; ++m) { const int row = EPI_ROWS(ai, m);
                const float* xrow = row < MP ? xp + (size_t)row * D : xs + (size_t)(row - MP) * D;
                const int nseq = row < MP ? (row >> 11) : NSEQ_P + ((row - MP) >> 2);
                const float* grow = gate + (size_t)nseq * D; float* orow = out + (size_t)row * D; float s = 0.f;
#pragma unroll
                for (int bj = 0; bj < 2; ++bj)
#pragma unroll
                    for (int n = 0; n < 2; ++n) { const int c = col0 + bj * HALF + 4 * n;
                        const f32x4 xv = *(const f32x4*)(xrow + c), gv = *(const f32x4*)(grow + c); const f32x4 r = xv + gv * acc[ai][bj][m][n];
                        *(f32x4*)(orow + c) = r; s += (r[0] * r[0] + r[1] * r[1]) + (r[2] * r[2] + r[3] * r[3]); }
                s += __shfl_xor(s, 16); s += __shfl_xor(s, 32);
                if (fq == 0) ssq[(size_t)row * 64 + u.pn * 4 + wc] = s; }
        return false;
    }
};
}

struct Args { const float* in[25]; float* out; unsigned char* ws; int ph_lo, ph_hi, coop, pad; };

__device__ __forceinline__ void transpose_item(const float* __restrict__ W, int N, bf16_t* WT, int ldt, int koff, LAS unsigned char* scr, int item, int lane) {
    const int nblk = N >> 6, kb = item / nblk, nb = item - kb * nblk, k0 = kb * 64, n0 = nb * 64;
    const int r4 = lane >> 4, c16 = lane & 15;
    const float* src = W + (size_t)(k0 + r4) * N + n0 + 4 * c16;
    f32x4 v[16];
#pragma unroll
    for (int i = 0; i < 16; ++i) v[i] = *(const f32x4*)(src + (size_t)(4 * i) * N);
#pragma unroll
    for (int i = 0; i < 16; ++i) { u32x2 w; w.x = cvt_pk_bf16(v[i][0], v[i][1]); w.y = cvt_pk_bf16(v[i][2], v[i][3]);
        *(LAS u32x2*)(scr + (4 * i + r4) * 192 + c16 * 8) = w; }
    asm volatile("s_waitcnt lgkmcnt(0)" ::: "memory");
    const int gq = lane >> 4, li = lane & 15, q = li >> 2, pp = li & 3;
    const unsigned rb = (unsigned)(q * 192 + (16 * gq + 4 * pp) * 2);
    bf16_t* dst = WT + (size_t)(n0 + 16 * gq + li) * ldt + koff + k0;
#pragma unroll
    for (int jj = 0; jj < 8; ++jj) {
        const v4i16_t d0 = __builtin_amdgcn_ds_read_tr16_b64_v4i16((LAS v4i16_t*)(scr + rb + (8 * jj) * 192));
        const v4i16_t d1 = __builtin_amdgcn_ds_read_tr16_b64_v4i16((LAS v4i16_t*)(scr + rb + (8 * jj + 4) * 192));
        bf16x8 o; o[0] = d0[0]; o[1] = d0[1]; o[2] = d0[2]; o[3] = d0[3]; o[4] = d1[0]; o[5] = d1[1]; o[6] = d1[2]; o[7] = d1[3];
        *(bf16x8*)(dst + 8 * jj) = o; }
    asm volatile("s_waitcnt lgkmcnt(0)" ::: "memory");
}

__device__ __forceinline__ void p0_convert(const Args& a, LAS unsigned char* lds, int gw, int NGW, int wave, int lane) {
    LAS unsigned char* scr = lds + wave * 12288;
    unsigned char* ws = a.ws;
    constexpr int I_ADA = 64 * 192, I_IN = 64 * 320, I_GLU = 32 * 32, I_PA = 32 * 64, I_PB = 32 * 64, I_O = 64 * 64;
    constexpr int NITEMS = I_ADA + I_IN + I_GLU + I_PA + I_PB + I_O;
    for (int it = gw; it < NITEMS; it += NGW) {
        int r = it;
        if (r < I_ADA) { transpose_item(a.in[7], 12288, (bf16_t*)(ws + WS_WADA), 4096, 0, scr, r, lane); continue; } r -= I_ADA;
        if (r < I_IN) { transpose_item(a.in[9], INC, (bf16_t*)(ws + WS_WIN), 4096, 0, scr, r, lane); continue; } r -= I_IN;
        if (r < I_GLU) { transpose_item(a.in[18], 2048, (bf16_t*)(ws + WS_WGLU), 2048, 0, scr, r, lane); continue; } r -= I_GLU;
        if (r < I_PA) { transpose_item(a.in[20], 4096, (bf16_t*)(ws + WS_WPAB), 4096, 0, scr, r, lane); continue; } r -= I_PA;
        if (r < I_PB) { transpose_item(a.in[22], 4096, (bf16_t*)(ws + WS_WPAB), 4096, 2048, scr, r, lane); continue; } r -= I_PB;
        transpose_item(a.in[23], 4096, (bf16_t*)(ws + WS_WO), 4096, 0, scr, r, lane);
    }
    bf16_t* sc = (bf16_t*)(ws + WS_SC);
    for (int i = gw * 64 + lane; i < 256 * 512; i += NGW * 64) {
        const int row = i >> 9, c8 = (i & 511) * 8; u32x4 w = (u32x4){0u, 0u, 0u, 0u};
        if (row < NMOD) { const float* src = (row < NSEQ_P ? a.in[4] + (size_t)row * D : a.in[5] + (size_t)(row - NSEQ_P) * D) + c8;
            const f32x4 x0 = *(const f32x4*)src, x1 = *(const f32x4*)(src + 4); float o[8];
#pragma unroll
            for (int j = 0; j < 4; ++j) { o[j] = x0[j] * sigmoidf_(x0[j]); o[4 + j] = x1[j] * sigmoidf_(x1[j]); }
            w.x = cvt_pk_bf16(o[0], o[1]); w.y = cvt_pk_bf16(o[2], o[3]); w.z = cvt_pk_bf16(o[4], o[5]); w.w = cvt_pk_bf16(o[6], o[7]); }
        *(u32x4*)(sc + (size_t)row * D + c8) = w;
    }
}

__device__ __forceinline__ void p2_xn(const Args& a, int gw, int NGW, int lane) {
    const float* modp = (const float*)(a.ws + WS_MODP); float* gate = (float*)(a.ws + WS_GATE); bf16_t* xn = (bf16_t*)(a.ws + WS_XN);
    const float* ng = a.in[6]; const float* bada = a.in[8];
    for (int it = gw; it < M / 4; it += NGW) {
        const int row0 = it * 4; const int nseq = row0 < MP ? (row0 >> 11) : NSEQ_P + ((row0 - MP) >> 2);
        const float* x0 = row0 < MP ? a.in[0] + (size_t)row0 * D : a.in[1] + (size_t)(row0 - MP) * D;
        float rstd[4];
#pragma unroll
        for (int r = 0; r < 4; ++r) { float s = 0.f;
#pragma unroll
            for (int j = 0; j < 16; ++j) { const f32x4 v = *(const f32x4*)(x0 + (size_t)r * D + j * 256 + lane * 4); s += (v[0] * v[0] + v[1] * v[1]) + (v[2] * v[2] + v[3] * v[3]); }
            rstd[r] = rsqrtf(wave_sum(s) * (1.0f / D) + EPS); }
        const bool wgate = row0 < MP ? ((row0 & (LP - 1)) == 0) : true;
        for (int j = 0; j < 16; ++j) { const int c = j * 256 + lane * 4;
            f32x4 sh = *(const f32x4*)(bada + c), scl = *(const f32x4*)(bada + D + c), gt = *(const f32x4*)(bada + 2 * D + c);
#pragma unroll
            for (int p = 0; p < 4; ++p) { const float* mp = modp + ((size_t)p * NMOD + nseq) * 12288 + c;
                sh += *(const f32x4*)mp; scl += *(const f32x4*)(mp + D); if (wgate) gt += *(const f32x4*)(mp + 2 * D); }
            if (wgate) *(f32x4*)(gate + (size_t)nseq * D + c) = gt;
            const f32x4 gg = *(const f32x4*)(ng + c); const f32x4 A = gg * (scl + 1.0f);
#pragma unroll
            for (int r = 0; r < 4; ++r) { const f32x4 v = *(const f32x4*)(x0 + (size_t)r * D + c); const f32x4 o = v * rstd[r] * A + sh;
                u32x2 w; w.x = cvt_pk_bf16(o[0], o[1]); w.y = cvt_pk_bf16(o[2], o[3]); *(u32x2*)(xn + (size_t)(row0 + r) * D + c) = w; } }
    }
}

struct S5C { f32x2 a0, a1; bf16x8 bfrag[4]; bf16x8 cfrag[4]; f32x4 dsk; };
__device__ __forceinline__ f32x2 cmul(f32x2 a, f32x2 b) { return (f32x2){a.x * b.x - a.y * b.y, a.x * b.y + a.y * b.x}; }

__device__ __forceinline__ void s5_setup(const Args& a, int g, int lane, S5C& C) {
    const int q = lane & 31, hh = lane >> 5;
    const float dt = expf(a.in[12][g]);
    f32x2 coef[2];
#pragma unroll
    for (int s = 0; s < 2; ++s) { const int p = q + 32 * s; const float lr = a.in[10][g * NST + p], li = a.in[11][g * NST + p];
        const float x = lr * dt, y = li * dt, ex = expf(x), sn = sinf(y), cs = cosf(y), s2 = sinf(0.5f * y);
        const f32x2 ab = (f32x2){ex * cs, ex * sn}; if (s == 0) C.a0 = ab; else C.a1 = ab;
        const float nr = expm1f(x) * cs - 2.0f * s2 * s2, ni = ex * sn, den = 1.0f / (lr * lr + li * li);
        coef[s] = (f32x2){(nr * lr + ni * li) * den, (ni * lr - nr * li) * den}; }
#pragma unroll
    for (int j = 0; j < 4; ++j) { const int s = j & 1, p = q + 32 * s, part = j >> 1; const f32x2 cf = coef[s];
        const float* br = a.in[13] + ((size_t)(g * NST + p)) * HG + 8 * hh; const float* bi = a.in[14] + ((size_t)(g * NST + p)) * HG + 8 * hh;
        const f32x4 r0 = *(const f32x4*)br, r1 = *(const f32x4*)(br + 4), i0 = *(const f32x4*)bi, i1 = *(const f32x4*)(bi + 4);
        f32x4 o0, o1;
        if (part == 0) { o0 = r0 * cf.x - i0 * cf.y; o1 = r1 * cf.x - i1 * cf.y; } else { o0 = i0 * cf.x + r0 * cf.y; o1 = i1 * cf.x + r1 * cf.y; }
        u32x4 w; w.x = cvt_pk_bf16(o0[0], o0[1]); w.y = cvt_pk_bf16(o0[2], o0[3]); w.z = cvt_pk_bf16(o1[0], o1[1]); w.w = cvt_pk_bf16(o1[2], o1[3]);
        C.bfrag[j] = __builtin_bit_cast(bf16x8, w); }
    const int hp = lane & 15, kq = lane >> 4;
#pragma unroll
    for (int ks = 0; ks < 4; ++ks) { const int p0 = 16 * ks + 4 * kq;
        const f32x4 cr = *(const f32x4*)(a.in[15] + ((size_t)(g * HG + hp)) * NST + p0), ci = *(const f32x4*)(a.in[16] + ((size_t)(g * HG + hp)) * NST + p0);
        u32x4 w; w.x = cvt_pk_bf16(cr[0], -ci[0]); w.y = cvt_pk_bf16(cr[1], -ci[1]); w.z = cvt_pk_bf16(cr[2], -ci[2]); w.w = cvt_pk_bf16(cr[3], -ci[3]);
        C.cfrag[ks] = __builtin_bit_cast(bf16x8, w); }
    C.dsk = *(const f32x4*)(a.in[17] + g * HG + 4 * kq);
}

template <int MODE>
__device__ __forceinline__ void s5_chunk(const Args& a, const S5C& C, int g, int lane, int rbA, int rbB, LAS unsigned char* img, f32x2& h0, f32x2& h1) {
    const bf16_t* proj = (const bf16_t*)(a.ws + WS_PROJ);
    const int q = lane & 31, hh = lane >> 5;
    { }
    const int ahalf = (q >> 2) & 1, ai_ = ((q >> 3) << 2) | (q & 3);
    const int arow = (ahalf ? rbB : rbA) + ai_;
    const bf16x8 af = *(const bf16x8*)(proj + (size_t)arow * INC + C_UA + g * HG + 8 * hh);
    f32x16 acc[4];
#pragma unroll
    for (int j = 0; j < 4; ++j) { f32x16 z;
#pragma unroll
        for (int e = 0; e < 16; ++e) z[e] = 0.f;
        acc[j] = __builtin_amdgcn_mfma_f32_32x32x16_bf16(af, C.bfrag[j], z, 0, 0, 0); }
    const int myrb = hh ? rbB : rbA;
#pragma unroll
    for (int i = 0; i < 16; ++i) {
        if (MODE == 2 && (i & 3) == 0) { const int n = (myrb - MP + i) >> 2; const float* sp = a.in[2] + ((size_t)(n * NG + g) * NST) * 2;
            h0 = *(const f32x2*)(sp + 2 * q); h1 = *(const f32x2*)(sp + 2 * (q + 32)); }
        const f32x2 n0 = (f32x2){C.a0.x * h0.x - C.a0.y * h0.y + acc[0][i], C.a0.x * h0.y + C.a0.y * h0.x + acc[2][i]};
        const f32x2 n1 = (f32x2){C.a1.x * h1.x - C.a1.y * h1.y + acc[1][i], C.a1.x * h1.y + C.a1.y * h1.x + acc[3][i]};
        h0 = n0; h1 = n1;
        if (MODE != 0) { LAS unsigned char* rowp = img + (16 * hh + i) * 272;
            *(LAS unsigned*)(rowp + 4 * q) = cvt_pk_bf16(h0.x, h0.y); *(LAS unsigned*)(rowp + 4 * (q + 32)) = cvt_pk_bf16(h1.x, h1.y); }
        if (MODE == 2 && (i & 3) == 3) { const int n = (myrb - MP + i) >> 2; float* op = a.out + O_SSM_S + ((size_t)(n * NG + g) * NST) * 2;
            *(f32x2*)(op + 2 * q) = h0; *(f32x2*)(op + 2 * (q + 32)) = h1; }
    }
    if (MODE != 0) {
        asm volatile("s_waitcnt lgkmcnt(0)" ::: "memory");
        const int t = lane & 15, kq = lane >> 4;
        bf16_t* ya = (bf16_t*)(a.ws + WS_YA);
#pragma unroll
        for (int tt = 0; tt < 2; ++tt) {
            f32x4 y = (f32x4){0.f, 0.f, 0.f, 0.f};
#pragma unroll
            for (int ks = 0; ks < 4; ++ks) { const bf16x8 hf = *(const LAS bf16x8*)(img + (16 * tt + t) * 272 + 64 * ks + 16 * kq);
                y = __builtin_amdgcn_mfma_f32_16x16x32_bf16(C.cfrag[ks], hf, y, 0, 0, 0); }
            const size_t row = (size_t)((tt ? rbB : rbA) + t);
            const u32x2 uw = *(const u32x2*)(proj + row * INC + C_UA + g * HG + 4 * kq);
            const f32x4 uv = (f32x4){bf_lo(uw.x), bf_hi(uw.x), bf_lo(uw.y), bf_hi(uw.y)};
            y += C.dsk * uv;
            f32x4 o;
#pragma unroll
            for (int e = 0; e < 4; ++e) { const float v = y[e]; const float z = 1.5957691216f * (v + 0.044715f * v * v * v); o[e] = v * sigmoidf_(z); }
            u32x2 w; w.x = cvt_pk_bf16(o[0], o[1]); w.y = cvt_pk_bf16(o[2], o[3]);
            *(u32x2*)(ya + row * SW + g * HG + 4 * kq) = w;
        }
        asm volatile("s_waitcnt lgkmcnt(0)" ::: "memory");
    }
}

template <int PASS>
__device__ __forceinline__ void s5_item(const Args& a, int w, int lane, LAS unsigned char* img) {
    const int g = w >> 4, pr = w & 15, q = lane & 31, hh = lane >> 5;
    S5C C; s5_setup(a, g, lane, C);
    const int nA = pr >> 3, j = pr & 7, nB = nA + 2;
    const int rbA = nA * LP + j * 256, rbB = nB * LP + j * 256;
    float* seg = (float*)(a.ws + WS_SEG);
    f32x2 h0 = (f32x2){0.f, 0.f}, h1 = (f32x2){0.f, 0.f};
    const int myn = hh ? nB : nA;
    if (PASS == 1) {
        f32x2 p0 = C.a0, p1 = C.a1;
#pragma unroll
        for (int s = 0; s < 8; ++s) { p0 = cmul(p0, p0); p1 = cmul(p1, p1); }
        for (int i = 0; i < j; ++i) { const f32x4 sv = *(const f32x4*)(seg + ((size_t)(g * 32 + myn * 8 + i) * 32 + q) * 4);
            h0 = cmul(p0, h0) + (f32x2){sv[0], sv[1]}; h1 = cmul(p1, h1) + (f32x2){sv[2], sv[3]}; }
    }
    for (int ck = 0; ck < 16; ++ck) s5_chunk<PASS>(a, C, g, lane, rbA + ck * 16, rbB + ck * 16, img, h0, h1);
    if (PASS == 0) {
        *(f32x4*)(seg + ((size_t)(g * 32 + myn * 8 + j) * 32 + q) * 4) = (f32x4){h0.x, h0.y, h1.x, h1.y};
    } else {
        if (j == 7) { float* op = a.out + O_SSM_P + ((size_t)(myn * NG + g) * NST) * 2; *(f32x2*)(op + 2 * q) = h0; *(f32x2*)(op + 2 * (q + 32)) = h1; }
        s5_chunk<2>(a, C, g, lane, MP + 32 * pr, MP + 32 * pr + 16, img, h0, h1);
    }
}

__device__ __forceinline__ void conv_item(const Args& a, int it, int lane) {
    const bf16_t* proj = (const bf16_t*)(a.ws + WS_PROJ); bf16_t* pab = (bf16_t*)(a.ws + WS_PAB);
    int r0, len, cb, n; bool sample, seqstart;
    if (it < 1024) { const int rs = it >> 2; cb = it & 3; r0 = rs * 32; len = 32; sample = false; seqstart = (r0 & (LP - 1)) == 0; n = r0 >> 11; }
    else { const int k = it - 1024; n = k >> 2; cb = k & 3; r0 = MP + 4 * n; len = 4; sample = true; seqstart = true; }
    const int ch0 = cb * 512 + lane * 8;
    float v1[8], v2[8], w0[8], w1[8], w2[8];
    { const float* cw = a.in[21];
#pragma unroll
      for (int e = 0; e < 8; e += 4) { const f32x4 x0 = *(const f32x4*)(cw + ch0 + e), x1 = *(const f32x4*)(cw + SW + ch0 + e), x2 = *(const f32x4*)(cw + 2 * SW + ch0 + e);
#pragma unroll
          for (int j = 0; j < 4; ++j) { w0[e + j] = x0[j]; w1[e + j] = x1[j]; w2[e + j] = x2[j]; } } }
    if (seqstart) {
        if (sample) { const float* sc = a.in[3] + (size_t)n * 2 * SW + ch0;
#pragma unroll
            for (int e = 0; e < 8; e += 4) { const f32x4 x2 = *(const f32x4*)(sc + e), x1 = *(const f32x4*)(sc + SW + e);
#pragma unroll
                for (int j = 0; j < 4; ++j) { v2[e + j] = x2[j]; v1[e + j] = x1[j]; } } }
        else {
#pragma unroll
            for (int e = 0; e < 8; ++e) { v1[e] = 0.f; v2[e] = 0.f; } }
    } else {
        float h[8], c[8];
        unpack8(*(const u32x4*)(proj + (size_t)(r0 - 2) * INC + C_HB + ch0), h); unpack8(*(const u32x4*)(proj + (size_t)(r0 - 2) * INC + C_CB + ch0), c);
#pragma unroll
        for (int e = 0; e < 8; ++e) v2[e] = c[e] * h[e];
        unpack8(*(const u32x4*)(proj + (size_t)(r0 - 1) * INC + C_HB + ch0), h); unpack8(*(const u32x4*)(proj + (size_t)(r0 - 1) * INC + C_CB + ch0), c);
#pragma unroll
        for (int e = 0; e < 8; ++e) v1[e] = c[e] * h[e];
    }
    for (int r = r0; r < r0 + len; ++r) {
        const bf16_t* pr = proj + (size_t)r * INC + ch0;
        float h[8], c[8], b[8], z[8], v[8], o[8];
        unpack8(*(const u32x4*)(pr + C_HB), h); unpack8(*(const u32x4*)(pr + C_CB), c); unpack8(*(const u32x4*)(pr + C_BB), b); unpack8(*(const u32x4*)(pr + C_ZB), z);
#pragma unroll
        for (int e = 0; e < 8; ++e) { v[e] = c[e] * h[e]; o[e] = b[e] * (w0[e] * v2[e] + w1[e] * v1[e] + w2[e] * v[e]) * z[e]; }
        u32x4 w; w.x = cvt_pk_bf16(o[0], o[1]); w.y = cvt_pk_bf16(o[2], o[3]); w.z = cvt_pk_bf16(o[4], o[5]); w.w = cvt_pk_bf16(o[6], o[7]);
        *(u32x4*)(pab + (size_t)r * D + SW + ch0) = w;
        const int pos = sample ? (r - r0) : (r & (LP - 1)), L = sample ? LS : LP;
        if (pos >= L - 2) { float* op = a.out + (sample ? O_CONV_S : O_CONV_P) + ((size_t)n * 2 + (pos - (L - 2))) * SW + ch0;
            *(f32x4*)op = (f32x4){v[0], v[1], v[2], v[3]}; *(f32x4*)(op + 4) = (f32x4){v[4], v[5], v[6], v[7]}; }
#pragma unroll
        for (int e = 0; e < 8; ++e) { v2[e] = v1[e]; v1[e] = v[e]; }
    }
}

__device__ __forceinline__ void p9_norm(const Args& a, int gw, int NGW, int lane) {
    const float* ssq = (const float*)(a.ws + WS_SSQ); const float* fg = a.in[24];
    for (int row = gw; row < M; row += NGW) {
        const float rstd = rsqrtf(wave_sum(ssq[(size_t)row * 64 + lane]) * (1.0f / D) + EPS);
        float* orow = a.out + (size_t)row * D;
#pragma unroll
        for (int j = 0; j < 16; ++j) { const int c = j * 256 + lane * 4; const f32x4 v = *(const f32x4*)(orow + c), gg = *(const f32x4*)(fg + c); *(f32x4*)(orow + c) = v * rstd * gg; }
    }
}

__global__ void __launch_bounds__(NTHREADS, 2) fwd_mega(Args args) {
    extern __shared__ __attribute__((aligned(16))) unsigned char lds_raw[];
    LAS unsigned char* lds = (LAS unsigned char*)lds_raw;
    const int tid = threadIdx.x, lane = tid & 63, wave = __builtin_amdgcn_readfirstlane(tid >> 6);
    const int G = gridDim.x, bx = blockIdx.x;
    const int gw = bx * NWAVES + wave, NGW = G * NWAVES;
    unsigned char* ws = args.ws;
    const int lo = args.ph_lo, hi = args.ph_hi;
#define IN(k) (lo <= (k) && (k) < hi)
#define SEAM(k) do { if (IN(k) && IN((k) + 1)) { if (args.coop) cg::this_grid().sync(); } } while (0)

    if (IN(0)) { p0_convert(args, lds, gw, NGW, wave, lane); } SEAM(0);
    if (IN(1)) { __syncthreads();
        pg8::Gemm g{(const bf16_t*)(ws + WS_SC), (const bf16_t*)(ws + WS_WADA), D, D, 1024}; pg8::SchedMod S{G, bx}; pg8::EpiMod E{(float*)(ws + WS_MODP)};
        pg8::gemm_phase(lds, g, S, E); } SEAM(1);
    if (IN(2)) { p2_xn(args, gw, NGW, lane); } SEAM(2);
    if (IN(3)) { __syncthreads();
        pg8::Gemm g{(const bf16_t*)(ws + WS_XN), (const bf16_t*)(ws + WS_WIN), D, D, D}; pg8::SchedPlain S; S.T.init(M, INC, G, bx); pg8::EpiProj E{(bf16_t*)(ws + WS_PROJ)};
        pg8::gemm_phase(lds, g, S, E); } SEAM(3);
    if (IN(4)) { __syncthreads();
        for (int w = gw; w < 2048; w += NGW) s5_item<0>(args, w, lane, lds + wave * 8704);
        for (int it = gw; it < 1536; it += NGW) conv_item(args, it, lane); } SEAM(4);
    if (IN(5)) { __syncthreads();
        for (int w = gw; w < 2048; w += NGW) s5_item<1>(args, w, lane, lds + wave * 8704); } SEAM(5);
    if (IN(6)) { __syncthreads();
        pg8::Gemm g{(const bf16_t*)(ws + WS_YA), (const bf16_t*)(ws + WS_WGLU), SW, SW, SW}; pg8::SchedPlain S; S.T.init(M, SW, G, bx);
        pg8::EpiGlu E{(const bf16_t*)(ws + WS_YA), (const bf16_t*)(ws + WS_PROJ), args.in[19], (bf16_t*)(ws + WS_PAB)};
        pg8::gemm_phase(lds, g, S, E); } SEAM(6);
    if (IN(7)) { __syncthreads();
        pg8::Gemm g{(const bf16_t*)(ws + WS_PAB), (const bf16_t*)(ws + WS_WPAB), D, D, SW}; pg8::SchedHalves S; S.T.init(M, D, G, bx);
        pg8::EpiBranch E{(const bf16_t*)(ws + WS_PROJ), (bf16_t*)(ws + WS_MERGED)};
        pg8::gemm_phase(lds, g, S, E); } SEAM(7);
    if (IN(8)) { __syncthreads();
        pg8::Gemm g{(const bf16_t*)(ws + WS_MERGED), (const bf16_t*)(ws + WS_WO), D, D, D}; pg8::SchedPlain S; S.T.init(M, D, G, bx);
        pg8::EpiOut E{args.in[0], args.in[1], (const float*)(ws + WS_GATE), args.out, (float*)(ws + WS_SSQ)};
        pg8::gemm_phase(lds, g, S, E); } SEAM(8);
    if (IN(9)) { p9_norm(args, gw, NGW, lane); }
#undef IN
#undef SEAM
}

extern "C" void kernel_launch(void* const* d_in, const int* in_sizes, int n_in, void* d_out, int out_size, void* d_ws, size_t ws_size, hipStream_t stream) {
    static int grid = 0;
    if (grid == 0) {
        if (n_in != 25 || ws_size < WS_END) { fprintf(stderr, "kernel_launch: unexpected n_in %d / ws %zu (need %zu)\n", n_in, ws_size, (size_t)WS_END); grid = -1; return; }
        int dev = 0, cus = 0, per_cu = 0;
        (void)hipGetDevice(&dev); (void)hipDeviceGetAttribute(&cus, hipDeviceAttributeMultiprocessorCount, dev);
        if (hipFuncSetAttribute((const void*)fwd_mega, hipFuncAttributeMaxDynamicSharedMemorySize, LDS_BYTES) != hipSuccess) { fprintf(stderr, "kernel_launch: hipFuncSetAttribute failed\n"); grid = -1; return; }
        if (hipOccupancyMaxActiveBlocksPerMultiprocessor(&per_cu, (const void*)fwd_mega, NTHREADS, LDS_BYTES) != hipSuccess || per_cu < 1) { fprintf(stderr, "kernel_launch: occupancy query says %d\n", per_cu); per_cu = 1; }
        (void)hipGetLastError();
        grid = cus * 1;
    }
    if (grid < 0) return;
    Args a{};
    for (int i = 0; i < 25; ++i) a.in[i] = (const float*)d_in[i];
    a.out = (float*)d_out; a.ws = (unsigned char*)d_ws;
#if MK_N_LAUNCHES == 1
    a.ph_lo = 0; a.ph_hi = 10; a.coop = 1;
    void* kargs[] = {&a};
    hipError_t e = hipLaunchCooperativeKernel((const void*)fwd_mega, dim3(grid), dim3(NTHREADS), kargs, LDS_BYTES, stream);
    if (e != hipSuccess) fprintf(stderr, "kernel_launch: cooperative launch failed: %s (grid %d)\n", hipGetErrorString(e), grid);
#else
    for (int p = 0; p < 10; ++p) { a.ph_lo = p; a.ph_hi = p + 1; a.coop = 0;
        hipLaunchKernelGGL(fwd_mega, dim3(grid), dim3(NTHREADS), LDS_BYTES, stream, a); }
#endif
}
```

```cpp
#include <hip/hip_runtime.h>
#include <hip/hip_cooperative_groups.h>
#include <cstdio>
#include <cstdint>
namespace cg = cooperative_groups;

#ifndef MK_N_LAUNCHES
#define MK_N_LAUNCHES 1
#endif

#ifndef PROBE_REP_MASK
#define PROBE_REP_MASK 0
#endif
#define REPS(k) (1 + ((PROBE_REP_MASK >> (k)) & 1))

#define LAS __attribute__((address_space(3)))
typedef unsigned short bf16_t;
typedef short bf16x8 __attribute__((ext_vector_type(8)));
typedef float f32x4 __attribute__((ext_vector_type(4)));
typedef float f32x2 __attribute__((ext_vector_type(2)));
typedef float f32x16 __attribute__((ext_vector_type(16)));
typedef unsigned u32x4 __attribute__((ext_vector_type(4)));
typedef unsigned u32x2 __attribute__((ext_vector_type(2)));
typedef short v4i16_t __attribute__((ext_vector_type(4)));

constexpr int D = 4096, MP = 8192, MS = 512, M = MP + MS, LP = 2048, LS = 4, NSEQ_P = 4, NSEQ_S = 128, NMOD = 132;
constexpr int INC = 20480, SW = 2048, NG = 128, NST = 64, HG = 16;
constexpr int C_UA = 0, C_ZA = 2048, C_HB = 4096, C_CB = 6144, C_BB = 8192, C_ZB = 10240, C_GA = 12288, C_GB = 16384;
constexpr float EPS = 1e-6f;
constexpr size_t O_Y = 0, O_SSM_P = (size_t)M * D, O_CONV_P = O_SSM_P + 65536, O_SSM_S = O_CONV_P + 16384, O_CONV_S = O_SSM_S + 2097152;

constexpr size_t MiB = 1u << 20;
constexpr size_t WS_WIN = 1 * MiB;
constexpr size_t WS_WGLU = WS_WIN + 160 * MiB;
constexpr size_t WS_WPAB = WS_WGLU + 8 * MiB;
constexpr size_t WS_WO = WS_WPAB + 32 * MiB;
constexpr size_t WS_WADA = WS_WO + 32 * MiB;
constexpr size_t WS_SC = WS_WADA + 96 * MiB;
constexpr size_t WS_MODP = WS_SC + 2 * MiB;
constexpr size_t WS_GATE = WS_MODP + 26 * MiB;
constexpr size_t WS_SEG = WS_GATE + 3 * MiB;
constexpr size_t WS_SSQ = WS_SEG + 2 * MiB;
constexpr size_t WS_XN = WS_SSQ + 3 * MiB;
constexpr size_t WS_PROJ = WS_XN + 68 * MiB;
constexpr size_t WS_YA = WS_PROJ + 340 * MiB;
constexpr size_t WS_PAB = WS_YA + 34 * MiB;
constexpr size_t WS_MERGED = WS_PAB + 68 * MiB;
constexpr size_t WS_END = WS_MERGED + 68 * MiB;

constexpr int NWAVES = 8, NTHREADS = 512;
constexpr int LDS_BYTES = 135168;

__device__ __forceinline__ unsigned cvt_pk_bf16(float lo, float hi) { unsigned r; asm volatile("v_cvt_pk_bf16_f32 %0, %1, %2" : "=v"(r) : "v"(lo), "v"(hi)); return r; }
__device__ __forceinline__ float bf_lo(unsigned w) { return __uint_as_float(w << 16); }
__device__ __forceinline__ float bf_hi(unsigned w) { return __uint_as_float(w & 0xffff0000u); }
__device__ __forceinline__ float sigmoidf_(float v) { return __builtin_amdgcn_rcpf(1.0f + __expf(-v)); }
__device__ __forceinline__ float wave_sum(float v) {
#pragma unroll
    for (int o = 1; o < 64; o <<= 1) v += __shfl_xor(v, o);
    return v;
}
__device__ __forceinline__ void unpack8(const u32x4 w, float (&f)[8]) {
    f[0] = bf_lo(w.x); f[1] = bf_hi(w.x); f[2] = bf_lo(w.y); f[3] = bf_hi(w.y); f[4] = bf_lo(w.z); f[5] = bf_hi(w.z); f[6] = bf_lo(w.w); f[7] = bf_hi(w.w);
}

namespace pg8 {
constexpr int BM = 256, BK = 64, HALF = 128, HTB = HALF * BK * 2, STAGE_BYTES = 8 * HTB, NXCD = 8, WGM = 8;
__host__ __device__ __forceinline__ int lds_byte(int r, int c) { const int st = (r >> 4) * 2 + (c >> 5), rr = r & 15, cc = c & 31, ob = rr * 64 + cc * 2; return st * 1024 + (ob ^ (((ob >> 9) & 1) << 5)); }
__host__ __device__ __forceinline__ void stage_rc(int b, int& R, int& C) { const int st = b / 1024, sb = b % 1024, swz = sb ^ (((sb >> 9) & 1) << 5); R = (st >> 1) * 16 + swz / 64; C = (st & 1) * 32 + (swz % 64) / 2; }
__host__ __device__ __forceinline__ int perm32(int rho) { const int n = rho >> 4, i = rho & 15; return 8 * (i >> 2) + 4 * n + (i & 3); }

struct Unit { int pm, pn, part; };
struct Gemm { const bf16_t* A; const bf16_t* Bt; int lda, ldb, K; };

struct TileOrder {
    int nM, nN, nwg, G, c;
    __device__ void init(int M_, int N_, int G_, int c_) { nM = M_ / BM; nN = N_ / BM; nwg = nM * nN; G = G_; c = c_; }
    __device__ bool tile(int i, int& pm, int& pn) const {
        const long L = (long)i * G + c; if (L >= nwg) return false;
        int wgid = (int)L; { const int q = nwg / NXCD, r = nwg % NXCD, xcd = wgid % NXCD, off = wgid / NXCD; wgid = (xcd < r ? xcd * (q + 1) : r * (q + 1) + (xcd - r) * q) + off; }
        const int nig = WGM * nN, gid = wgid / nig, fm = gid * WGM, gsz = (nM - fm) < WGM ? (nM - fm) : WGM;
        pm = fm + ((wgid % nig) % gsz); pn = (wgid % nig) / gsz; return true;
    }
};
struct SchedPlain { TileOrder T; __device__ bool next(int i, Unit& u) const { u.part = 0; return T.tile(i, u.pm, u.pn); } };
struct SchedHalves { TileOrder T; __device__ bool next(int i, Unit& u) const { u.part = i & 1; return T.tile(i >> 1, u.pm, u.pn); } };
struct SchedMod { int G, c; __device__ bool next(int i, Unit& u) const { const int L = i * G + c; if (L >= 192) return false; u.pm = 0; u.pn = L % 48; u.part = L / 48; return true; } };

typedef f32x4 Acc[2][2][4][2];

template <class Epi, class Sched>
__device__ __forceinline__ void gemm_phase(LAS unsigned char* lds, const Gemm g, const Sched& S, const Epi& E) {
    const int tid = threadIdx.x, wid = __builtin_amdgcn_readfirstlane(tid >> 6), lane = tid & 63, wr = wid >> 2, wc = wid & 3, fr = lane & 15, fq = lane >> 4;
    const int K = g.K, nt = K / BK;
    unsigned voffA[2], voffB[2];
#pragma unroll
    for (int i = 0; i < 2; ++i) { int R, C; stage_rc(tid * 16 + i * 8192, R, C); const int Rb = (R & ~31) + perm32(R & 31);
        voffA[i] = (unsigned)(R * g.lda + C) * 2u; voffB[i] = (unsigned)(Rb * g.ldb + C) * 2u; }
    const size_t kstep = (size_t)(BK * 2);
    const size_t hstepA = (size_t)HALF * g.lda * 2, hstepB = (size_t)HALF * g.ldb * 2;
    const unsigned ldsw = (unsigned)wid * 1024u;
    const int aoff = lds_byte(wr * 64 + fr, fq * 8), boff = lds_byte(wc * 32 + fr, fq * 8);
#define PG8_SA(b, h) (((b) * 2 + (h)) * HTB)
#define PG8_SB(b, h) ((4 + (b) * 2 + (h)) * HTB)
#define PG8_STAGE(bufoff, gbase, voff) do { _Pragma("unroll") for (int _i = 0; _i < 2; ++_i) \
        __builtin_amdgcn_global_load_lds((const unsigned*)((const char*)(gbase) + (voff)[_i]), (LAS unsigned*)(lds + (bufoff) + ldsw + _i * 8192), 16, 0, 0); } while (0)
#define PG8_LDA(dst, b, h) do { _Pragma("unroll") for (int m = 0; m < 4; ++m) _Pragma("unroll") for (int k = 0; k < 2; ++k) dst[m][k] = *(const LAS bf16x8*)(lds + PG8_SA(b, h) + aoff + m * 2048 + k * 1024); } while (0)
#define PG8_LDB(dst, b, h) do { _Pragma("unroll") for (int n = 0; n < 2; ++n) _Pragma("unroll") for (int k = 0; k < 2; ++k) dst[n][k] = *(const LAS bf16x8*)(lds + PG8_SB(b, h) + boff + n * 2048 + k * 1024); } while (0)
#define PG8_MMA(ai, bj, At, Bt) do { __builtin_amdgcn_s_setprio(1); _Pragma("unroll") for (int m = 0; m < 4; ++m) _Pragma("unroll") for (int n = 0; n < 2; ++n) _Pragma("unroll") for (int k = 0; k < 2; ++k) \
        acc[ai][bj][m][n] = __builtin_amdgcn_mfma_f32_16x16x32_bf16(Bt[n][k], At[m][k], acc[ai][bj][m][n], 0, 0, 0); __builtin_amdgcn_s_setprio(0); } while (0)
#define PG8_WAIT_V(n) asm volatile("s_waitcnt vmcnt(" #n ")" ::: "memory")
#define PG8_WAIT_L(n) asm volatile("s_waitcnt lgkmcnt(" #n ")" ::: "memory")
#define PG8_BAR __builtin_amdgcn_s_barrier()
#define PG8_SCHED __builtin_amdgcn_sched_barrier(0)
    Unit cur, nxt; int ui = 0;
    if (!S.next(0, cur)) return;
    Acc acc;
#pragma unroll
    for (int a = 0; a < 2; ++a)
#pragma unroll
        for (int b = 0; b < 2; ++b)
#pragma unroll
            for (int m = 0; m < 4; ++m)
#pragma unroll
                for (int n = 0; n < 2; ++n) acc[a][b][m][n] = (f32x4){0.f, 0.f, 0.f, 0.f};
    bf16x8 At[4][2], B0[2][2], B1[2][2];
    const char* cA = (const char*)g.A + ((size_t)cur.pm * BM * g.lda + (size_t)cur.part * K) * 2;
    const char* cB = (const char*)g.Bt + ((size_t)cur.pn * BM * g.ldb + (size_t)cur.part * K) * 2;
    PG8_STAGE(PG8_SB(0, 0), cB, voffB); PG8_STAGE(PG8_SB(0, 1), cB + hstepB, voffB); PG8_STAGE(PG8_SA(0, 0), cA, voffA); PG8_STAGE(PG8_SA(0, 1), cA + hstepA, voffA);
    if (wr == 1) PG8_BAR;
    PG8_WAIT_V(2); PG8_BAR;
    PG8_STAGE(PG8_SB(1, 0), cB + kstep, voffB); PG8_STAGE(PG8_SA(1, 0), cA + kstep, voffA); PG8_STAGE(PG8_SB(1, 1), cB + hstepB + kstep, voffB);
    PG8_WAIT_V(6); PG8_BAR;
    for (;;) {
        const bool has_next = S.next(ui + 1, nxt);
        const char* nA = has_next ? (const char*)g.A + ((size_t)nxt.pm * BM * g.lda + (size_t)nxt.part * K) * 2 : cA;
        const char* nB = has_next ? (const char*)g.Bt + ((size_t)nxt.pn * BM * g.ldb + (size_t)nxt.part * K) * 2 : cB;
        for (int t = 0; t < nt; t += 2) {
            const bool last = (t == nt - 2);
            const char* a1 = cA + (size_t)(t + 1) * kstep;
            const char* a2 = last ? nA : cA + (size_t)(t + 2) * kstep; const char* b2 = last ? nB : cB + (size_t)(t + 2) * kstep;
            const char* a3 = a2 + kstep; const char* b3 = b2 + kstep;
            PG8_LDB(B0, 0, 0); PG8_LDB(B1, 0, 1); PG8_SCHED; PG8_LDA(At, 0, 0); PG8_STAGE(PG8_SA(1, 1), a1 + hstepA, voffA);
            PG8_WAIT_V(8); PG8_WAIT_L(0); PG8_BAR; PG8_MMA(0, 0, At, B0); PG8_MMA(0, 1, At, B1); PG8_BAR; PG8_SCHED;
            PG8_LDA(At, 0, 1); PG8_STAGE(PG8_SB(0, 0), b2, voffB); PG8_STAGE(PG8_SB(0, 1), b2 + hstepB, voffB); PG8_STAGE(PG8_SA(0, 0), a2, voffA);
            PG8_WAIT_V(8); PG8_WAIT_L(0); PG8_BAR; PG8_MMA(1, 0, At, B0); PG8_MMA(1, 1, At, B1); PG8_BAR; PG8_SCHED;
            PG8_LDB(B0, 1, 0); PG8_LDB(B1, 1, 1); PG8_SCHED; PG8_LDA(At, 1, 0); PG8_STAGE(PG8_SA(0, 1), a2 + hstepA, voffA);
            PG8_WAIT_V(8); PG8_WAIT_L(0); PG8_BAR; PG8_MMA(0, 0, At, B0); PG8_MMA(0, 1, At, B1); PG8_BAR; PG8_SCHED;
            PG8_LDA(At, 1, 1); PG8_STAGE(PG8_SB(1, 0), b3, voffB); PG8_STAGE(PG8_SB(1, 1), b3 + hstepB, voffB); PG8_STAGE(PG8_SA(1, 0), a3, voffA);
            PG8_WAIT_V(8); PG8_WAIT_L(0); PG8_BAR; PG8_MMA(1, 0, At, B0); PG8_MMA(1, 1, At, B1); PG8_BAR; PG8_SCHED;
        }
        if (wr == 0) PG8_BAR;
        const bool keep = E(acc, cur, wr, wc, fr, fq);
        if (!has_next) break;
        if (!keep) {
#pragma unroll
            for (int a = 0; a < 2; ++a)
#pragma unroll
                for (int b = 0; b < 2; ++b)
#pragma unroll
                    for (int m = 0; m < 4; ++m)
#pragma unroll
                        for (int n = 0; n < 2; ++n) acc[a][b][m][n] = (f32x4){0.f, 0.f, 0.f, 0.f};
        }
        cur = nxt; cA = nA; cB = nB; ++ui;
        if (wr == 1) PG8_BAR;
    }
    PG8_WAIT_V(0);
    PG8_BAR;
#undef PG8_SA
#undef PG8_SB
#undef PG8_STAGE
#undef PG8_LDA
#undef PG8_LDB
#undef PG8_MMA
#undef PG8_WAIT_V
#undef PG8_WAIT_L
#undef PG8_BAR
#undef PG8_SCHED
}

#define EPI_ROWS(ai, m) (u.pm * BM + (ai) * HALF + wr * 64 + (m) * 16 + fr)
#define EPI_COL0 (u.pn * BM + wc * 32 + 8 * fq)

struct EpiMod {
    float* modp;
    __device__ __forceinline__ bool operator()(Acc& acc, const Unit& u, int wr, int wc, int fr, int fq) const {
        const int col0 = EPI_COL0;
#pragma unroll
        for (int ai = 0; ai < 2; ++ai)
#pragma unroll
            for (int m = 0; m < 4; ++m) { const int row = EPI_ROWS(ai, m);
                if (row < NMOD) { float* rowp = modp + ((size_t)u.part * NMOD + row) * 12288 + col0;
#pragma unroll
                    for (int bj = 0; bj < 2; ++bj) { *(f32x4*)(rowp + bj * HALF) = acc[ai][bj][m][0]; *(f32x4*)(rowp + bj * HALF + 4) = acc[ai][bj][m][1]; } } }
        return false;
    }
};
struct EpiProj {
    bf16_t* O;
    __device__ __forceinline__ bool operator()(Acc& acc, const Unit& u, int wr, int wc, int fr, int fq) const {
        const int col0 = EPI_COL0; const int cb = u.pn >> 3;
        const int act = (cb == 1 || cb == 5) ? 1 : (cb >= 6 ? 2 : 0);
#pragma unroll
        for (int ai = 0; ai < 2; ++ai)
#pragma unroll
            for (int m = 0; m < 4; ++m) { bf16_t* rowp = O + (size_t)EPI_ROWS(ai, m) * INC + col0;
#pragma unroll
                for (int bj = 0; bj < 2; ++bj) { f32x4 v0 = acc[ai][bj][m][0], v1 = acc[ai][bj][m][1];
                    if (act) {
#pragma unroll
                        for (int j = 0; j < 4; ++j) { const float s0 = sigmoidf_(v0[j]), s1 = sigmoidf_(v1[j]); v0[j] = act == 1 ? v0[j] * s0 : s0; v1[j] = act == 1 ? v1[j] * s1 : s1; } }
                    u32x4 w; w.x = cvt_pk_bf16(v0[0], v0[1]); w.y = cvt_pk_bf16(v0[2], v0[3]); w.z = cvt_pk_bf16(v1[0], v1[1]); w.w = cvt_pk_bf16(v1[2], v1[3]);
                    *(u32x4*)(rowp + bj * HALF) = w; } }
        return false;
    }
};
struct EpiGlu {
    const bf16_t* ya; const bf16_t* proj; const float* bglu; bf16_t* pab;
    __device__ __forceinline__ bool operator()(Acc& acc, const Unit& u, int wr, int wc, int fr, int fq) const {
        const int col0 = EPI_COL0;
        f32x4 bv[2][2];
#pragma unroll
        for (int bj = 0; bj < 2; ++bj) { bv[bj][0] = *(const f32x4*)(bglu + col0 + bj * HALF); bv[bj][1] = *(const f32x4*)(bglu + col0 + bj * HALF + 4); }
#pragma unroll
        for (int ai = 0; ai < 2; ++ai)
#pragma unroll
            for (int m = 0; m < 4; ++m) { const size_t row = EPI_ROWS(ai, m);
#pragma unroll
                for (int bj = 0; bj < 2; ++bj) {
                    const u32x4 yw = *(const u32x4*)(ya + row * SW + col0 + bj * HALF), zw = *(const u32x4*)(proj + row * INC + C_ZA + col0 + bj * HALF);
                    float y[8], z[8], o[8]; unpack8(yw, y); unpack8(zw, z);
                    const f32x4 t0 = acc[ai][bj][m][0] + bv[bj][0], t1 = acc[ai][bj][m][1] + bv[bj][1];
#pragma unroll
                    for (int j = 0; j < 4; ++j) { o[j] = y[j] * sigmoidf_(t0[j]) * z[j]; o[4 + j] = y[4 + j] * sigmoidf_(t1[j]) * z[4 + j]; }
                    u32x4 w; w.x = cvt_pk_bf16(o[0], o[1]); w.y = cvt_pk_bf16(o[2], o[3]); w.z = cvt_pk_bf16(o[4], o[5]); w.w = cvt_pk_bf16(o[6], o[7]);
                    *(u32x4*)(pab + row * D + col0 + bj * HALF) = w; } }
        return false;
    }
};
struct EpiBranch {
    const bf16_t* proj; bf16_t* merged;
    __device__ __forceinline__ bool operator()(Acc& acc, const Unit& u, int wr, int wc, int fr, int fq) const {
        const int col0 = EPI_COL0;
#pragma unroll
        for (int ai = 0; ai < 2; ++ai)
#pragma unroll
            for (int m = 0; m < 4; ++m) { const size_t row = EPI_ROWS(ai, m);
#pragma unroll
                for (int bj = 0; bj < 2; ++bj) {
                    const u32x4 gbw = *(const u32x4*)(proj + row * INC + C_GB + col0 + bj * HALF); float gb[8]; unpack8(gbw, gb);
                    if (u.part == 0) {
                        const u32x4 gaw = *(const u32x4*)(proj + row * INC + C_GA + col0 + bj * HALF); float ga[8]; unpack8(gaw, ga);
#pragma unroll
                        for (int j = 0; j < 4; ++j) { acc[ai][bj][m][0][j] *= ga[j] * __builtin_amdgcn_rcpf(fmaxf(gb[j], 1e-30f)); acc[ai][bj][m][1][j] *= ga[4 + j] * __builtin_amdgcn_rcpf(fmaxf(gb[4 + j], 1e-30f)); }
                    } else {
                        float o[8];
#pragma unroll
                        for (int j = 0; j < 4; ++j) { o[j] = acc[ai][bj][m][0][j] * fmaxf(gb[j], 1e-30f); o[4 + j] = acc[ai][bj][m][1][j] * fmaxf(gb[4 + j], 1e-30f); }
                        u32x4 w; w.x = cvt_pk_bf16(o[0], o[1]); w.y = cvt_pk_bf16(o[2], o[3]); w.z = cvt_pk_bf16(o[4], o[5]); w.w = cvt_pk_bf16(o[6], o[7]);
                        *(u32x4*)(merged + row * D + col0 + bj * HALF) = w; } } }
        return u.part == 0;
    }
};
struct EpiOut {
    const float* xp; const float* xs; const float* gate; float* out; float* ssq;
    __device__ __forceinline__ bool operator()(Acc& acc, const Unit& u, int wr, int wc, int fr, int fq) const {
        const int col0 = EPI_COL0;
#pragma unroll
        for (int ai = 0; ai < 2; ++ai)
#pragma unroll
            for (int m = 0; m < 4; ++m) { const int row = EPI_ROWS(ai, m);
                const float* xrow = row < MP ? xp + (size_t)row * D : xs + (size_t)(row - MP) * D;
                const int nseq = row < MP ? (row >> 11) : NSEQ_P + ((row - MP) >> 2);
                const float* grow = gate + (size_t)nseq * D; float* orow = out + (size_t)row * D; float s = 0.f;
#pragma unroll
                for (int bj = 0; bj < 2; ++bj)
#pragma unroll
                    for (int n = 0; n < 2; ++n) { const int c = col0 + bj * HALF + 4 * n;
                        const f32x4 xv = *(const f32x4*)(xrow + c), gv = *(const f32x4*)(grow + c); const f32x4 r = xv + gv * acc[ai][bj][m][n];
                        *(f32x4*)(orow + c) = r; s += (r[0] * r[0] + r[1] * r[1]) + (r[2] * r[2] + r[3] * r[3]); }
                s += __shfl_xor(s, 16); s += __shfl_xor(s, 32);
                if (fq == 0) ssq[(size_t)row * 64 + u.pn * 4 + wc] = s; }
        return false;
    }
};
}

struct Args { const float* in[25]; float* out; unsigned char* ws; int ph_lo, ph_hi, coop, pad; };

__device__ __forceinline__ void transpose_item(const float* __restrict__ W, int N, bf16_t* WT, int ldt, int koff, LAS unsigned char* scr, int item, int lane) {
    const int nblk = N >> 6, kb = item / nblk, nb = item - kb * nblk, k0 = kb * 64, n0 = nb * 64;
    const int r4 = lane >> 4, c16 = lane & 15;
    const float* src = W + (size_t)(k0 + r4) * N + n0 + 4 * c16;
    f32x4 v[16];
#pragma unroll
    for (int i = 0; i < 16; ++i) v[i] = *(const f32x4*)(src + (size_t)(4 * i) * N);
#pragma unroll
    for (int i = 0; i < 16; ++i) { u32x2 w; w.x = cvt_pk_bf16(v[i][0], v[i][1]); w.y = cvt_pk_bf16(v[i][2], v[i][3]);
        *(LAS u32x2*)(scr + (4 * i + r4) * 192 + c16 * 8) = w; }
    asm volatile("s_waitcnt lgkmcnt(0)" ::: "memory");
    const int gq = lane >> 4, li = lane & 15, q = li >> 2, pp = li & 3;
    const unsigned rb = (unsigned)(q * 192 + (16 * gq + 4 * pp) * 2);
    bf16_t* dst = WT + (size_t)(n0 + 16 * gq + li) * ldt + koff + k0;
#pragma unroll
    for (int jj = 0; jj < 8; ++jj) {
        const v4i16_t d0 = __builtin_amdgcn_ds_read_tr16_b64_v4i16((LAS v4i16_t*)(scr + rb + (8 * jj) * 192));
        const v4i16_t d1 = __builtin_amdgcn_ds_read_tr16_b64_v4i16((LAS v4i16_t*)(scr + rb + (8 * jj + 4) * 192));
        bf16x8 o; o[0] = d0[0]; o[1] = d0[1]; o[2] = d0[2]; o[3] = d0[3]; o[4] = d1[0]; o[5] = d1[1]; o[6] = d1[2]; o[7] = d1[3];
        *(bf16x8*)(dst + 8 * jj) = o; }
    asm volatile("s_waitcnt lgkmcnt(0)" ::: "memory");
}

__device__ __forceinline__ void p0_convert(const Args& a, LAS unsigned char* lds, int gw, int NGW, int wave, int lane) {
    LAS unsigned char* scr = lds + wave * 12288;
    unsigned char* ws = a.ws;
    constexpr int I_ADA = 64 * 192, I_IN = 64 * 320, I_GLU = 32 * 32, I_PA = 32 * 64, I_PB = 32 * 64, I_O = 64 * 64;
    constexpr int NITEMS = I_ADA + I_IN + I_GLU + I_PA + I_PB + I_O;
    for (int it = gw; it < NITEMS; it += NGW) {
        int r = it;
        if (r < I_ADA) { transpose_item(a.in[7], 12288, (bf16_t*)(ws + WS_WADA), 4096, 0, scr, r, lane); continue; } r -= I_ADA;
        if (r < I_IN) { transpose_item(a.in[9], INC, (bf16_t*)(ws + WS_WIN), 4096, 0, scr, r, lane); continue; } r -= I_IN;
        if (r < I_GLU) { transpose_item(a.in[18], 2048, (bf16_t*)(ws + WS_WGLU), 2048, 0, scr, r, lane); continue; } r -= I_GLU;
        if (r < I_PA) { transpose_item(a.in[20], 4096, (bf16_t*)(ws + WS_WPAB), 4096, 0, scr, r, lane); continue; } r -= I_PA;
        if (r < I_PB) { transpose_item(a.in[22], 4096, (bf16_t*)(ws + WS_WPAB), 4096, 2048, scr, r, lane); continue; } r -= I_PB;
        transpose_item(a.in[23], 4096, (bf16_t*)(ws + WS_WO), 4096, 0, scr, r, lane);
    }
    bf16_t* sc = (bf16_t*)(ws + WS_SC);
    for (int i = gw * 64 + lane; i < 256 * 512; i += NGW * 64) {
        const int row = i >> 9, c8 = (i & 511) * 8; u32x4 w = (u32x4){0u, 0u, 0u, 0u};
        if (row < NMOD) { const float* src = (row < NSEQ_P ? a.in[4] + (size_t)row * D : a.in[5] + (size_t)(row - NSEQ_P) * D) + c8;
            const f32x4 x0 = *(const f32x4*)src, x1 = *(const f32x4*)(src + 4); float o[8];
#pragma unroll
            for (int j = 0; j < 4; ++j) { o[j] = x0[j] * sigmoidf_(x0[j]); o[4 + j] = x1[j] * sigmoidf_(x1[j]); }
            w.x = cvt_pk_bf16(o[0], o[1]); w.y = cvt_pk_bf16(o[2], o[3]); w.z = cvt_pk_bf16(o[4], o[5]); w.w = cvt_pk_bf16(o[6], o[7]); }
        *(u32x4*)(sc + (size_t)row * D + c8) = w;
    }
}

__device__ __forceinline__ void p2_xn(const Args& a, int gw, int NGW, int lane) {
    const float* modp = (const float*)(a.ws + WS_MODP); float* gate = (float*)(a.ws + WS_GATE); bf16_t* xn = (bf16_t*)(a.ws + WS_XN);
    const float* ng = a.in[6]; const float* bada = a.in[8];
    for (int it = gw; it < M / 4; it += NGW) {
        const int row0 = it * 4; const int nseq = row0 < MP ? (row0 >> 11) : NSEQ_P + ((row0 - MP) >> 2);
        const float* x0 = row0 < MP ? a.in[0] + (size_t)row0 * D : a.in[1] + (size_t)(row0 - MP) * D;
        float rstd[4];
#pragma unroll
        for (int r = 0; r < 4; ++r) { float s = 0.f;
#pragma unroll
            for (int j = 0; j < 16; ++j) { const f32x4 v = *(const f32x4*)(x0 + (size_t)r * D + j * 256 + lane * 4); s += (v[0] * v[0] + v[1] * v[1]) + (v[2] * v[2] + v[3] * v[3]); }
            rstd[r] = rsqrtf(wave_sum(s) * (1.0f / D) + EPS); }
        const bool wgate = row0 < MP ? ((row0 & (LP - 1)) == 0) : true;
        for (int j = 0; j < 16; ++j) { const int c = j * 256 + lane * 4;
            f32x4 sh = *(const f32x4*)(bada + c), scl = *(const f32x4*)(bada + D + c), gt = *(const f32x4*)(bada + 2 * D + c);
#pragma unroll
            for (int p = 0; p < 4; ++p) { const float* mp = modp + ((size_t)p * NMOD + nseq) * 12288 + c;
                sh += *(const f32x4*)mp; scl += *(const f32x4*)(mp + D); if (wgate) gt += *(const f32x4*)(mp + 2 * D); }
            if (wgate) *(f32x4*)(gate + (size_t)nseq * D + c) = gt;
            const f32x4 gg = *(const f32x4*)(ng + c); const f32x4 A = gg * (scl + 1.0f);
#pragma unroll
            for (int r = 0; r < 4; ++r) { const f32x4 v = *(const f32x4*)(x0 + (size_t)r * D + c); const f32x4 o = v * rstd[r] * A + sh;
                u32x2 w; w.x = cvt_pk_bf16(o[0], o[1]); w.y = cvt_pk_bf16(o[2], o[3]); *(u32x2*)(xn + (size_t)(row0 + r) * D + c) = w; } }
    }
}

struct S5C { f32x2 a0, a1; bf16x8 bfrag[4]; bf16x8 cfrag[4]; f32x4 dsk; };
__device__ __forceinline__ f32x2 cmul(f32x2 a, f32x2 b) { return (f32x2){a.x * b.x - a.y * b.y, a.x * b.y + a.y * b.x}; }

__device__ __forceinline__ void s5_setup(const Args& a, int g, int lane, S5C& C) {
    const int q = lane & 31, hh = lane >> 5;
    const float dt = expf(a.in[12][g]);
    f32x2 coef[2];
#pragma unroll
    for (int s = 0; s < 2; ++s) { const int p = q + 32 * s; const float lr = a.in[10][g * NST + p], li = a.in[11][g * NST + p];
        const float x = lr * dt, y = li * dt, ex = expf(x), sn = sinf(y), cs = cosf(y), s2 = sinf(0.5f * y);
        const f32x2 ab = (f32x2){ex * cs, ex * sn}; if (s == 0) C.a0 = ab; else C.a1 = ab;
        const float nr = expm1f(x) * cs - 2.0f * s2 * s2, ni = ex * sn, den = 1.0f / (lr * lr + li * li);
        coef[s] = (f32x2){(nr * lr + ni * li) * den, (ni * lr - nr * li) * den}; }
#pragma unroll
    for (int j = 0; j < 4; ++j) { const int s = j & 1, p = q + 32 * s, part = j >> 1; const f32x2 cf = coef[s];
        const float* br = a.in[13] + ((size_t)(g * NST + p)) * HG + 8 * hh; const float* bi = a.in[14] + ((size_t)(g * NST + p)) * HG + 8 * hh;
        const f32x4 r0 = *(const f32x4*)br, r1 = *(const f32x4*)(br + 4), i0 = *(const f32x4*)bi, i1 = *(const f32x4*)(bi + 4);
        f32x4 o0, o1;
        if (part == 0) { o0 = r0 * cf.x - i0 * cf.y; o1 = r1 * cf.x - i1 * cf.y; } else { o0 = i0 * cf.x + r0 * cf.y; o1 = i1 * cf.x + r1 * cf.y; }
        u32x4 w; w.x = cvt_pk_bf16(o0[0], o0[1]); w.y = cvt_pk_bf16(o0[2], o0[3]); w.z = cvt_pk_bf16(o1[0], o1[1]); w.w = cvt_pk_bf16(o1[2], o1[3]);
        C.bfrag[j] = __builtin_bit_cast(bf16x8, w); }
    const int hp = lane & 15, kq = lane >> 4;
#pragma unroll
    for (int ks = 0; ks < 4; ++ks) { const int p0 = 16 * ks + 4 * kq;
        const f32x4 cr = *(const f32x4*)(a.in[15] + ((size_t)(g * HG + hp)) * NST + p0), ci = *(const f32x4*)(a.in[16] + ((size_t)(g * HG + hp)) * NST + p0);
        u32x4 w; w.x = cvt_pk_bf16(cr[0], -ci[0]); w.y = cvt_pk_bf16(cr[1], -ci[1]); w.z = cvt_pk_bf16(cr[2], -ci[2]); w.w = cvt_pk_bf16(cr[3], -ci[3]);
        C.cfrag[ks] = __builtin_bit_cast(bf16x8, w); }
    C.dsk = *(const f32x4*)(a.in[17] + g * HG + 4 * kq);
}

template <int MODE>
__device__ __forceinline__ void s5_chunk(const Args& a, const S5C& C, int g, int lane, int rbA, int rbB, LAS unsigned char* img, f32x2& h0, f32x2& h1) {
    const bf16_t* proj = (const bf16_t*)(a.ws + WS_PROJ);
    const int q = lane & 31, hh = lane >> 5;
    { }
    const int ahalf = (q >> 2) & 1, ai_ = ((q >> 3) << 2) | (q & 3);
    const int arow = (ahalf ? rbB : rbA) + ai_;
    const bf16x8 af = *(const bf16x8*)(proj + (size_t)arow * INC + C_UA + g * HG + 8 * hh);
    f32x16 acc[4];
#pragma unroll
    for (int j = 0; j < 4; ++j) { f32x16 z;
#pragma unroll
        for (int e = 0; e < 16; ++e) z[e] = 0.f;
        acc[j] = __builtin_amdgcn_mfma_f32_32x32x16_bf16(af, C.bfrag[j], z, 0, 0, 0); }
    const int myrb = hh ? rbB : rbA;
#pragma unroll
    for (int i = 0; i < 16; ++i) {
        if (MODE == 2 && (i & 3) == 0) { const int n = (myrb - MP + i) >> 2; const float* sp = a.in[2] + ((size_t)(n * NG + g) * NST) * 2;
            h0 = *(const f32x2*)(sp + 2 * q); h1 = *(const f32x2*)(sp + 2 * (q + 32)); }
        const f32x2 n0 = (f32x2){C.a0.x * h0.x - C.a0.y * h0.y + acc[0][i], C.a0.x * h0.y + C.a0.y * h0.x + acc[2][i]};
        const f32x2 n1 = (f32x2){C.a1.x * h1.x - C.a1.y * h1.y + acc[1][i], C.a1.x * h1.y + C.a1.y * h1.x + acc[3][i]};
        h0 = n0; h1 = n1;
        if (MODE != 0) { LAS unsigned char* rowp = img + (16 * hh + i) * 272;
            *(LAS unsigned*)(rowp + 4 * q) = cvt_pk_bf16(h0.x, h0.y); *(LAS unsigned*)(rowp + 4 * (q + 32)) = cvt_pk_bf16(h1.x, h1.y); }
        if (MODE == 2 && (i & 3) == 3) { const int n = (myrb - MP + i) >> 2; float* op = a.out + O_SSM_S + ((size_t)(n * NG + g) * NST) * 2;
            *(f32x2*)(op + 2 * q) = h0; *(f32x2*)(op + 2 * (q + 32)) = h1; }
    }
    if (MODE != 0) {
        asm volatile("s_waitcnt lgkmcnt(0)" ::: "memory");
        const int t = lane & 15, kq = lane >> 4;
        bf16_t* ya = (bf16_t*)(a.ws + WS_YA);
#pragma unroll
        for (int tt = 0; tt < 2; ++tt) {
            f32x4 y = (f32x4){0.f, 0.f, 0.f, 0.f};
#pragma unroll
            for (int ks = 0; ks < 4; ++ks) { const bf16x8 hf = *(const LAS bf16x8*)(img + (16 * tt + t) * 272 + 64 * ks + 16 * kq);
                y = __builtin_amdgcn_mfma_f32_16x16x32_bf16(C.cfrag[ks], hf, y, 0, 0, 0); }
            const size_t row = (size_t)((tt ? rbB : rbA) + t);
            const u32x2 uw = *(const u32x2*)(proj + row * INC + C_UA + g * HG + 4 * kq);
            const f32x4 uv = (f32x4){bf_lo(uw.x), bf_hi(uw.x), bf_lo(uw.y), bf_hi(uw.y)};
            y += C.dsk * uv;
            f32x4 o;
#pragma unroll
            for (int e = 0; e < 4; ++e) { const float v = y[e]; const float z = 1.5957691216f * (v + 0.044715f * v * v * v); o[e] = v * sigmoidf_(z); }
            u32x2 w; w.x = cvt_pk_bf16(o[0], o[1]); w.y = cvt_pk_bf16(o[2], o[3]);
            *(u32x2*)(ya + row * SW + g * HG + 4 * kq) = w;
        }
        asm volatile("s_waitcnt lgkmcnt(0)" ::: "memory");
    }
}

template <int PASS>
__device__ __forceinline__ void s5_item(const Args& a, int w, int lane, LAS unsigned char* img) {
    const int g = w >> 4, pr = w & 15, q = lane & 31, hh = lane >> 5;
    S5C C; s5_setup(a, g, lane, C);
    const int nA = pr >> 3, j = pr & 7, nB = nA + 2;
    const int rbA = nA * LP + j * 256, rbB = nB * LP + j * 256;
    float* seg = (float*)(a.ws + WS_SEG);
    f32x2 h0 = (f32x2){0.f, 0.f}, h1 = (f32x2){0.f, 0.f};
    const int myn = hh ? nB : nA;
    if (PASS == 1) {
        f32x2 p0 = C.a0, p1 = C.a1;
#pragma unroll
        for (int s = 0; s < 8; ++s) { p0 = cmul(p0, p0); p1 = cmul(p1, p1); }
        for (int i = 0; i < j; ++i) { const f32x4 sv = *(const f32x4*)(seg + ((size_t)(g * 32 + myn * 8 + i) * 32 + q) * 4);
            h0 = cmul(p0, h0) + (f32x2){sv[0], sv[1]}; h1 = cmul(p1, h1) + (f32x2){sv[2], sv[3]}; }
    }
    for (int ck = 0; ck < 16; ++ck) s5_chunk<PASS>(a, C, g, lane, rbA + ck * 16, rbB + ck * 16, img, h0, h1);
    if (PASS == 0) {
        *(f32x4*)(seg + ((size_t)(g * 32 + myn * 8 + j) * 32 + q) * 4) = (f32x4){h0.x, h0.y, h1.x, h1.y};
    } else {
        if (j == 7) { float* op = a.out + O_SSM_P + ((size_t)(myn * NG + g) * NST) * 2; *(f32x2*)(op + 2 * q) = h0; *(f32x2*)(op + 2 * (q + 32)) = h1; }
        s5_chunk<2>(a, C, g, lane, MP + 32 * pr, MP + 32 * pr + 16, img, h0, h1);
    }
}

__device__ __forceinline__ void conv_item(const Args& a, int it, int lane) {
    const bf16_t* proj = (const bf16_t*)(a.ws + WS_PROJ); bf16_t* pab = (bf16_t*)(a.ws + WS_PAB);
    int r0, len, cb, n; bool sample, seqstart;
    if (it < 1024) { const int rs = it >> 2; cb = it & 3; r0 = rs * 32; len = 32; sample = false; seqstart = (r0 & (LP - 1)) == 0; n = r0 >> 11; }
    else { const int k = it - 1024; n = k >> 2; cb = k & 3; r0 = MP + 4 * n; len = 4; sample = true; seqstart = true; }
    const int ch0 = cb * 512 + lane * 8;
    float v1[8], v2[8], w0[8], w1[8], w2[8];
    { const float* cw = a.in[21];
#pragma unroll
      for (int e = 0; e < 8; e += 4) { const f32x4 x0 = *(const f32x4*)(cw + ch0 + e), x1 = *(const f32x4*)(cw + SW + ch0 + e), x2 = *(const f32x4*)(cw + 2 * SW + ch0 + e);
#pragma unroll
          for (int j = 0; j < 4; ++j) { w0[e + j] = x0[j]; w1[e + j] = x1[j]; w2[e + j] = x2[j]; } } }
    if (seqstart) {
        if (sample) { const float* sc = a.in[3] + (size_t)n * 2 * SW + ch0;
#pragma unroll
            for (int e = 0; e < 8; e += 4) { const f32x4 x2 = *(const f32x4*)(sc + e), x1 = *(const f32x4*)(sc + SW + e);
#pragma unroll
                for (int j = 0; j < 4; ++j) { v2[e + j] = x2[j]; v1[e + j] = x1[j]; } } }
        else {
#pragma unroll
            for (int e = 0; e < 8; ++e) { v1[e] = 0.f; v2[e] = 0.f; } }
    } else {
        float h[8], c[8];
        unpack8(*(const u32x4*)(proj + (size_t)(r0 - 2) * INC + C_HB + ch0), h); unpack8(*(const u32x4*)(proj + (size_t)(r0 - 2) * INC + C_CB + ch0), c);
#pragma unroll
        for (int e = 0; e < 8; ++e) v2[e] = c[e] * h[e];
        unpack8(*(const u32x4*)(proj + (size_t)(r0 - 1) * INC + C_HB + ch0), h); unpack8(*(const u32x4*)(proj + (size_t)(r0 - 1) * INC + C_CB + ch0), c);
#pragma unroll
        for (int e = 0; e < 8; ++e) v1[e] = c[e] * h[e];
    }
    for (int r = r0; r < r0 + len; ++r) {
        const bf16_t* pr = proj + (size_t)r * INC + ch0;
        float h[8], c[8], b[8], z[8], v[8], o[8];
        unpack8(*(const u32x4*)(pr + C_HB), h); unpack8(*(const u32x4*)(pr + C_CB), c); unpack8(*(const u32x4*)(pr + C_BB), b); unpack8(*(const u32x4*)(pr + C_ZB), z);
#pragma unroll
        for (int e = 0; e < 8; ++e) { v[e] = c[e] * h[e]; o[e] = b[e] * (w0[e] * v2[e] + w1[e] * v1[e] + w2[e] * v[e]) * z[e]; }
        u32x4 w; w.x = cvt_pk_bf16(o[0], o[1]); w.y = cvt_pk_bf16(o[2], o[3]); w.z = cvt_pk_bf16(o[4], o[5]); w.w = cvt_pk_bf16(o[6], o[7]);
        *(u32x4*)(pab + (size_t)r * D + SW + ch0) = w;
        const int pos = sample ? (r - r0) : (r & (LP - 1)), L = sample ? LS : LP;
        if (pos >= L - 2) { float* op = a.out + (sample ? O_CONV_S : O_CONV_P) + ((size_t)n * 2 + (pos - (L - 2))) * SW + ch0;
            *(f32x4*)op = (f32x4){v[0], v[1], v[2], v[3]}; *(f32x4*)(op + 4) = (f32x4){v[4], v[5], v[6], v[7]}; }
#pragma unroll
        for (int e = 0; e < 8; ++e) { v2[e] = v1[e]; v1[e] = v[e]; }
    }
}

__device__ __forceinline__ void p9_norm(const Args& a, int gw, int NGW, int lane) {
    const float* ssq = (const float*)(a.ws + WS_SSQ); const float* fg = a.in[24];
    for (int row = gw; row < M; row += NGW) {
        const float rstd = rsqrtf(wave_sum(ssq[(size_t)row * 64 + lane]) * (1.0f / D) + EPS);
        float* orow = a.out + (size_t)row * D;
#pragma unroll
        for (int j = 0; j < 16; ++j) { const int c = j * 256 + lane * 4; const f32x4 v = *(const f32x4*)(orow + c), gg = *(const f32x4*)(fg + c); *(f32x4*)(orow + c) = v * rstd * gg; }
    }
}

#define XB_TMO      128
#define XB_XCNT(j)  (256  + 64 * (j))
#define XB_XSUB(j)  (1280 + 64 * (j))
#define XB_XGEN(j)  (2304 + 64 * (j))
#define XB_TOP      3328
#define XB_TOPGEN   3392
#define XCD_BAR_WORDS 3456
#define XB_SPIN_CAP (1u << 18)

__device__ __forceinline__ unsigned xb_ld(unsigned* p)              { return __hip_atomic_load(p, __ATOMIC_RELAXED, __HIP_MEMORY_SCOPE_AGENT); }
__device__ __forceinline__ unsigned xb_add(unsigned* p, unsigned v) { return __hip_atomic_fetch_add(p, v, __ATOMIC_RELAXED, __HIP_MEMORY_SCOPE_AGENT); }
__device__ __forceinline__ unsigned xb_xcc_id() { return (unsigned)__builtin_amdgcn_s_getreg((3 << 11) | 20) & 0xFu; }
#define XB_SPIN(cond, bar) do { unsigned _sp = 0; while (cond) { __builtin_amdgcn_s_sleep(1); \
    if ((++_sp & 255u) == 0u) { if (xb_ld(&(bar)[XB_TMO])) break; if (_sp > XB_SPIN_CAP) { atomicAdd(&(bar)[XB_TMO], 1u); break; } } } } while (0)

struct XcdBarrier {
    unsigned* bar; unsigned x;
    volatile LAS unsigned* st;
};

__device__ __forceinline__ XcdBarrier xcd_barrier_post(unsigned* bar, volatile LAS unsigned* st) {
    XcdBarrier b; b.bar = bar; b.x = xb_xcc_id(); b.st = st;
    if (threadIdx.x == 0) (void)xb_add(&bar[XB_XCNT(b.x)], 1u);
    return b;
}
__device__ __forceinline__ void xcd_barrier_complete(unsigned* bar, unsigned x, unsigned& nloc, unsigned& nx) {
    const unsigned G = gridDim.x * gridDim.y * gridDim.z;
    unsigned sum, cnt, mine, sp = 0u;
    for (;;) {
        sum = 0u; cnt = 0u; mine = 0u;
#pragma unroll
        for (unsigned j = 0; j < 16; ++j) { const unsigned c = xb_ld(&bar[XB_XCNT(j)]); sum += c; cnt += (c > 0u) ? 1u : 0u; mine = (j == x) ? c : mine; }
        if (sum == G) break;
        __builtin_amdgcn_s_sleep(1);
        if ((++sp & 255u) == 0u) { if (xb_ld(&bar[XB_TMO])) break; if (sp > XB_SPIN_CAP) { atomicAdd(&bar[XB_TMO], 1u); break; } }
    }
    nloc = mine > 0u ? mine : 1u; nx = cnt > 0u ? cnt : 1u;
}

__device__ __forceinline__ void xcd_barrier(const XcdBarrier& b) {
    asm volatile("s_waitcnt vmcnt(0)" ::: "memory");
    __syncthreads();
    if (threadIdx.x == 0) {
        unsigned* bar = b.bar;
        __builtin_amdgcn_s_waitcnt(0);
        unsigned nloc = b.st[0], nx = b.st[1];
        if (nloc == 0u) { xcd_barrier_complete(bar, b.x, nloc, nx); b.st[0] = nloc; b.st[1] = nx; }
        const unsigned old = xb_add(&bar[XB_XSUB(b.x)], 1u);
        const unsigned gen = old / nloc;
        if (old + 1u == (gen + 1u) * nloc) {
            __builtin_amdgcn_fence(__ATOMIC_RELEASE, "agent");
            asm volatile("s_waitcnt vmcnt(0)" ::: "memory");
            const unsigned og = xb_add(&bar[XB_TOP], 1u);
            const unsigned tg = og / nx;
            if (og + 1u == (tg + 1u) * nx) xb_add(&bar[XB_TOPGEN], 1u);
            else XB_SPIN(xb_ld(&bar[XB_TOPGEN]) == tg, bar);
            __builtin_amdgcn_fence(__ATOMIC_ACQUIRE, "agent");
            xb_add(&bar[XB_XGEN(b.x)], 1u);
            asm volatile("s_waitcnt vmcnt(0)" ::: "memory");
        } else {
            XB_SPIN(xb_ld(&bar[XB_XGEN(b.x)]) == gen, bar);
            __builtin_amdgcn_fence(__ATOMIC_ACQUIRE, "agent");
            asm volatile("s_waitcnt vmcnt(0)" ::: "memory");
        }
    }
    __syncthreads();
}

__global__ void __launch_bounds__(NTHREADS, 2) fwd_mega(Args args) {
    extern __shared__ __attribute__((aligned(16))) unsigned char lds_raw[];
    LAS unsigned char* lds = (LAS unsigned char*)lds_raw;
    const int tid = threadIdx.x, lane = tid & 63, wave = __builtin_amdgcn_readfirstlane(tid >> 6);
    const int G = gridDim.x, bx = blockIdx.x;
    const int gw = bx * NWAVES + wave, NGW = G * NWAVES;
    unsigned char* ws = args.ws;
    const int lo = args.ph_lo, hi = args.ph_hi;
#define IN(k) (lo <= (k) && (k) < hi)
    volatile LAS unsigned* xst = (volatile LAS unsigned*)(lds + 131072);
    if (tid < 2) xst[tid] = 0u;
    __syncthreads();
    XcdBarrier bar; bar.bar = (unsigned*)ws; bar.x = 0; bar.st = xst;
    if (args.coop) bar = xcd_barrier_post((unsigned*)ws, xst);
    if (args.pad == 0x5eed) cg::this_grid().sync();
#define SEAM(k) do { if (IN(k) && IN((k) + 1)) { if (args.coop) xcd_barrier(bar); } } while (0)

    if (IN(0)) for (int rep = 0; rep < REPS(0); ++rep) { p0_convert(args, lds, gw, NGW, wave, lane); } SEAM(0);
    if (IN(1)) for (int rep = 0; rep < REPS(1); ++rep) { __syncthreads();
        pg8::Gemm g{(const bf16_t*)(ws + WS_SC), (const bf16_t*)(ws + WS_WADA), D, D, 1024}; pg8::SchedMod S{G, bx}; pg8::EpiMod E{(float*)(ws + WS_MODP)};
        pg8::gemm_phase(lds, g, S, E); } SEAM(1);
    if (IN(2)) for (int rep = 0; rep < REPS(2); ++rep) { p2_xn(args, gw, NGW, lane); } SEAM(2);
    if (IN(3)) for (int rep = 0; rep < REPS(3); ++rep) { __syncthreads();
        pg8::Gemm g{(const bf16_t*)(ws + WS_XN), (const bf16_t*)(ws + WS_WIN), D, D, D}; pg8::SchedPlain S; S.T.init(M, INC, G, bx); pg8::EpiProj E{(bf16_t*)(ws + WS_PROJ)};
        pg8::gemm_phase(lds, g, S, E); } SEAM(3);
    if (IN(4)) for (int rep = 0; rep < REPS(4); ++rep) { __syncthreads();
        for (int w = gw; w < 2048; w += NGW) s5_item<0>(args, w, lane, lds + wave * 8704);
        for (int it = gw; it < 1536; it += NGW) conv_item(args, it, lane); } SEAM(4);
    if (IN(5)) for (int rep = 0; rep < REPS(5); ++rep) { __syncthreads();
        for (int w = gw; w < 2048; w += NGW) s5_item<1>(args, w, lane, lds + wave * 8704); } SEAM(5);
    if (IN(6)) for (int rep = 0; rep < REPS(6); ++rep) { __syncthreads();
        pg8::Gemm g{(const bf16_t*)(ws + WS_YA), (const bf16_t*)(ws + WS_WGLU), SW, SW, SW}; pg8::SchedPlain S; S.T.init(M, SW, G, bx);
        pg8::EpiGlu E{(const bf16_t*)(ws + WS_YA), (const bf16_t*)(ws + WS_PROJ), args.in[19], (bf16_t*)(ws + WS_PAB)};
        pg8::gemm_phase(lds, g, S, E); } SEAM(6);
    if (IN(7)) for (int rep = 0; rep < REPS(7); ++rep) { __syncthreads();
        pg8::Gemm g{(const bf16_t*)(ws + WS_PAB), (const bf16_t*)(ws + WS_WPAB), D, D, SW}; pg8::SchedHalves S; S.T.init(M, D, G, bx);
        pg8::EpiBranch E{(const bf16_t*)(ws + WS_PROJ), (bf16_t*)(ws + WS_MERGED)};
        pg8::gemm_phase(lds, g, S, E); } SEAM(7);
    if (IN(8)) for (int rep = 0; rep < REPS(8); ++rep) { __syncthreads();
        pg8::Gemm g{(const bf16_t*)(ws + WS_MERGED), (const bf16_t*)(ws + WS_WO), D, D, D}; pg8::SchedPlain S; S.T.init(M, D, G, bx);
        pg8::EpiOut E{args.in[0], args.in[1], (const float*)(ws + WS_GATE), args.out, (float*)(ws + WS_SSQ)};
        pg8::gemm_phase(lds, g, S, E); } SEAM(8);
    if (IN(9)) for (int rep = 0; rep < REPS(9); ++rep) { p9_norm(args, gw, NGW, lane); }
#undef IN
#undef SEAM
}

extern "C" void kernel_launch(void* const* d_in, const int* in_sizes, int n_in, void* d_out, int out_size, void* d_ws, size_t ws_size, hipStream_t stream) {
    static int grid = 0;
    if (grid == 0) {
        if (n_in != 25 || ws_size < WS_END) { fprintf(stderr, "kernel_launch: unexpected n_in %d / ws %zu (need %zu)\n", n_in, ws_size, (size_t)WS_END); grid = -1; return; }
        int dev = 0, cus = 0, per_cu = 0;
        (void)hipGetDevice(&dev); (void)hipDeviceGetAttribute(&cus, hipDeviceAttributeMultiprocessorCount, dev);
        if (hipFuncSetAttribute((const void*)fwd_mega, hipFuncAttributeMaxDynamicSharedMemorySize, LDS_BYTES) != hipSuccess) { fprintf(stderr, "kernel_launch: hipFuncSetAttribute failed\n"); grid = -1; return; }
        if (hipOccupancyMaxActiveBlocksPerMultiprocessor(&per_cu, (const void*)fwd_mega, NTHREADS, LDS_BYTES) != hipSuccess || per_cu < 1) { fprintf(stderr, "kernel_launch: occupancy query says %d\n", per_cu); per_cu = 1; }
        (void)hipGetLastError();
        grid = cus * 1;
    }
    if (grid < 0) return;
    Args a{};
    for (int i = 0; i < 25; ++i) a.in[i] = (const float*)d_in[i];
    a.out = (float*)d_out; a.ws = (unsigned char*)d_ws;
#if MK_N_LAUNCHES == 1
    a.ph_lo = 0; a.ph_hi = 10; a.coop = 1;
    if (hipMemsetAsync(d_ws, 0, 65536, stream) != hipSuccess) { fprintf(stderr, "kernel_launch: memset failed\n"); return; }
    void* kargs[] = {&a};
    hipError_t e = hipLaunchCooperativeKernel((const void*)fwd_mega, dim3(grid), dim3(NTHREADS), kargs, LDS_BYTES, stream);
    if (e != hipSuccess) fprintf(stderr, "kernel_launch: cooperative launch failed: %s (grid %d)\n", hipGetErrorString(e), grid);
#else
    for (int p = 0; p < 10; ++p) { a.ph_lo = p; a.ph_hi = p + 1; a.coop = 0;
        hipLaunchKernelGGL(fwd_mega, dim3(grid), dim3(NTHREADS), LDS_BYTES, stream, a); }
#endif
}
```
